# Optimizing an MI355X kernel written in HIP

```python
import jax, jax.numpy as jnp
from jax import lax
import numpy as np

D_MODEL = 1024
BATCH = 8
SEQ = 2048
DEPTH = 4
DEC_BATCH = 128
DEC_SEQ = 8
PAST_LEN = 16384
PAGE_SIZE = 128

N_MIXERS = 2
N_LRU = (DEPTH + 1) // 2
N_RWKV = DEPTH // 2
D_RNN = D_MODEL
LRU_BLOCKS = 4
LRU_BLOCK_W = D_RNN // LRU_BLOCKS
CONV_W = 4
RG_C = 8.0
HEAD_SIZE = 64
RWKV_HEADS = D_MODEL // HEAD_SIZE
D_DECAY_LORA = 64
D_AAA_LORA = 64
D_MV_LORA = 32
D_GATE_LORA = 160
D_FF = 2816
FFN_RES = 0.5
N_MOD = 9
NORM_EPS = 1e-6
GN_EPS = HEAD_SIZE * 1e-5

kernel_name = 'hybrid_rglru_rwkv7_adaln_macaron_step'


def rms_norm(x):
    xf = x.astype(jnp.float32)
    return (xf * lax.rsqrt(jnp.mean(xf * xf, axis=-1, keepdims=True) + NORM_EPS)).astype(x.dtype)


def modulate(x, shift, scale):
    return rms_norm(x) * (1.0 + scale) + shift


def swiglu(h, w_in, w_out):
    gate, up = jnp.split(h @ w_in, 2, axis=-1)
    return (jax.nn.silu(gate) * up) @ w_out


def causal_conv(x, buf, w, b):
    T = x.shape[1]
    xp = jnp.concatenate([buf.astype(x.dtype), x], axis=1)
    y = b
    for j in range(CONV_W):
        y = y + xp[:, j:j + T] * w[j]
    return y, xp[:, T:]


def linear_scan(a, u, h0):
    def comb(l, r):
        return l[0] * r[0], r[0] * l[1] + r[1]
    a_cum, u_cum = lax.associative_scan(comb, (a, u), axis=1)
    hs = a_cum * h0[:, None, :] + u_cum
    return hs, hs[:, -1]


def rglru_block(h, h0, conv_buf, w_in, conv_w, conv_b, gate_w, gate_b, lam, w_out):
    B, T, _ = h.shape
    gate_branch, rec = jnp.split(h @ w_in, 2, axis=-1)
    xc, new_buf = causal_conv(rec, conv_buf, conv_w, conv_b)
    xf = xc.astype(jnp.float32)
    gates = jnp.einsum('btnc,ncg->btng', xf.reshape(B, T, LRU_BLOCKS, LRU_BLOCK_W), gate_w) + gate_b
    r = jax.nn.sigmoid(gates[..., :LRU_BLOCK_W]).reshape(B, T, D_RNN)
    i = jax.nn.sigmoid(gates[..., LRU_BLOCK_W:]).reshape(B, T, D_RNN)
    log_a = RG_C * r * jax.nn.log_sigmoid(lam.astype(jnp.float32))
    a = jnp.exp(log_a)
    u = jnp.sqrt(-jnp.expm1(2.0 * log_a)) * (i * xf)
    hs, h_last = linear_scan(a, u, h0.astype(jnp.float32))
    y = (hs.astype(h.dtype) * jax.nn.gelu(gate_branch)) @ w_out
    return y, h_last, new_buf


def wkv_scan(r, w, k, v, a, b, S0):
    def step(S, inp):
        r_t, w_t, k_t, v_t, a_t, b_t = inp
        sa = jnp.einsum('bhvk,bhk->bhv', S, a_t)
        S = S * w_t[:, :, None, :] + sa[..., None] * b_t[:, :, None, :] + v_t[..., None] * k_t[:, :, None, :]
        return S, jnp.einsum('bhvk,bhk->bhv', S, r_t)
    seq = tuple(jnp.moveaxis(t, 1, 0) for t in (r, w, k, v, a, b))
    S_T, ys = lax.scan(step, S0, seq)
    return jnp.moveaxis(ys, 0, 1), S_T


def rwkv7_time_mix(h, shift0, S0, mu, w_rkv, w_o, w0, w1, w2, a0, a1, a2, g1, g2,
                   k_k, k_a, r_k, ln_w, ln_b, v_first, vres):
    B, T, D = h.shape
    xf = h.astype(jnp.float32)
    x_prev = jnp.concatenate([shift0.astype(jnp.float32)[:, None, :], xf[:, :-1]], axis=1)
    xm = xf[None] + (x_prev - xf)[None] * mu[:, None, None, :]
    r, k, v = jnp.einsum('jbtd,jde->jbte', xm[:3], w_rkv)
    w_log = -jax.nn.softplus(-(w0 + jnp.tanh(xm[3] @ w1) @ w2)) - 0.5
    decay = jnp.exp(-jnp.exp(w_log))
    if vres is not None:
        v0, v1, v2 = vres
        v = v + (v_first - v) * jax.nn.sigmoid(v0 + (xm[2] @ v1) @ v2)
    a = jax.nn.sigmoid(a0 + (xm[4] @ a1) @ a2)
    g = jax.nn.sigmoid(xm[5] @ g1) @ g2
    kk = (k * k_k).reshape(B, T, RWKV_HEADS, HEAD_SIZE)
    kk = kk / jnp.maximum(jnp.sqrt(jnp.sum(kk * kk, axis=-1, keepdims=True)), 1e-12)
    k = k * (1.0 + (a - 1.0) * k_a)
    rh, wh, kh, vh, ah = (t.reshape(B, T, RWKV_HEADS, HEAD_SIZE) for t in (r, decay, k, v, a))
    ys, S_T = wkv_scan(rh, wh, kh, vh, -kk, kk * ah, S0.astype(jnp.float32))
    mean = jnp.mean(ys, axis=-1, keepdims=True)
    var = jnp.mean(jnp.square(ys - mean), axis=-1, keepdims=True)
    yn = ((ys - mean) * lax.rsqrt(var + GN_EPS)).reshape(B, T, D) * ln_w + ln_b
    bonus = jnp.sum(rh * kh * r_k, axis=-1, keepdims=True) * vh
    out = ((yn + bonus.reshape(B, T, D)) * g) @ w_o
    return out.astype(h.dtype), xf[:, -1], S_T, v


def trunk(x, c, lru_h0, lru_conv0, rwkv_shift0, rwkv_wkv0, P):
    B = x.shape[0]
    new_h, new_conv, new_shift, new_wkv = [], [], [], []
    v_first = None
    for layer in range(DEPTH):
        j = layer // N_MIXERS
        mod = (jax.nn.silu(c) @ P['ada_w'][layer] + P['ada_b'][layer]).reshape(B, N_MOD, D_MODEL)
        sh1, sc1, g1, sh2, sc2, g2, sh3, sc3, g3 = [mod[:, m, None, :] for m in range(N_MOD)]
        x = x + FFN_RES * (1.0 + g1) * swiglu(modulate(x, sh1, sc1), P['ffn_w_in'][layer, 0], P['ffn_w_out'][layer, 0])
        h = modulate(x, sh2, sc2)
        if layer % N_MIXERS == 0:
            y, h_last, buf = rglru_block(h, lru_h0[j], lru_conv0[j], P['lru_w_in'][j], P['lru_conv_w'][j],
                                         P['lru_conv_b'][j], P['lru_gate_w'][j], P['lru_gate_b'][j],
                                         P['lru_lambda'][j], P['lru_w_out'][j])
            new_h.append(h_last)
            new_conv.append(buf)
        else:
            vres = None if j == 0 else (P['rwkv_v0'][j - 1], P['rwkv_v1'][j - 1], P['rwkv_v2'][j - 1])
            y, shift_last, S_T, v = rwkv7_time_mix(
                h, rwkv_shift0[j], rwkv_wkv0[j], P['rwkv_mu'][j], P['rwkv_w_rkv'][j], P['rwkv_w_o'][j],
                P['rwkv_w0'][j], P['rwkv_w1'][j], P['rwkv_w2'][j], P['rwkv_a0'][j], P['rwkv_a1'][j],
                P['rwkv_a2'][j], P['rwkv_g1'][j], P['rwkv_g2'][j], P['rwkv_k_k'][j], P['rwkv_k_a'][j],
                P['rwkv_r_k'][j], P['rwkv_ln_w'][j], P['rwkv_ln_b'][j], v_first, vres)
            if v_first is None:
                v_first = v
            new_shift.append(shift_last)
            new_wkv.append(S_T)
        x = x + (1.0 + g2) * y
        x = x + FFN_RES * (1.0 + g3) * swiglu(modulate(x, sh3, sc3), P['ffn_w_in'][layer, 1], P['ffn_w_out'][layer, 1])
    y = rms_norm(x) * P['final_gain']
    return y, jnp.stack(new_h), jnp.stack(new_conv), jnp.stack(new_shift), jnp.stack(new_wkv)


def setup_inputs(seed: int = 0) -> dict:
    key = jax.random.key(seed)
    ks = iter(jax.random.split(key, 48))

    def nrm(shape, scale):
        return jax.random.normal(next(ks), shape, jnp.float32) * scale

    def unif(shape, lo, hi):
        return jax.random.uniform(next(ks), shape, jnp.float32, lo, hi)

    D = D_MODEL
    x_prompt = nrm((BATCH, SEQ, D), 1.0)
    x_sample = nrm((DEC_BATCH, DEC_SEQ, D), 1.0)
    state_lru_h = nrm((N_LRU, DEC_BATCH, D_RNN), 0.5)
    state_lru_conv = nrm((N_LRU, DEC_BATCH, CONV_W - 1, D_RNN), 1.0)
    state_rwkv_shift = nrm((N_RWKV, DEC_BATCH, D), 1.0)
    state_rwkv_wkv = nrm((N_RWKV, DEC_BATCH, RWKV_HEADS, HEAD_SIZE, HEAD_SIZE), 1.0)
    c_prompt = nrm((BATCH, D), 1.0)
    c_sample = nrm((DEC_BATCH, D), 1.0)
    ada_w = nrm((DEPTH, D, N_MOD * D), 0.2 * D ** -0.5)
    ada_b = nrm((DEPTH, N_MOD * D), 0.02)
    ffn_w_in = nrm((DEPTH, 2, D, 2 * D_FF), D ** -0.5)
    ffn_w_out = nrm((DEPTH, 2, D_FF, D), D_FF ** -0.5)
    lru_w_in = nrm((N_LRU, D, 2 * D_RNN), D ** -0.5)
    lru_conv_w = nrm((N_LRU, CONV_W, D_RNN), CONV_W ** -0.5)
    lru_conv_b = nrm((N_LRU, D_RNN), 0.02)
    lru_gate_w = nrm((N_LRU, LRU_BLOCKS, LRU_BLOCK_W, 2 * LRU_BLOCK_W), LRU_BLOCK_W ** -0.5)
    lru_gate_b = nrm((N_LRU, LRU_BLOCKS, 2 * LRU_BLOCK_W), 0.02)
    a_target = unif((N_LRU, D_RNN), 0.9, 0.999)
    p = a_target ** (1.0 / RG_C)
    lru_lambda = jnp.log(p) - jnp.log1p(-p)
    lru_w_out = nrm((N_LRU, D_RNN, D), D_RNN ** -0.5)
    rwkv_mu = unif((N_RWKV, 6, D), 0.0, 1.0)
    rwkv_w_rkv = nrm((N_RWKV, 3, D, D), D ** -0.5)
    rwkv_w_o = nrm((N_RWKV, D, D), D ** -0.5)
    rwkv_w0 = unif((N_RWKV, D), -6.0, 1.0)
    rwkv_w1 = nrm((N_RWKV, D, D_DECAY_LORA), D ** -0.5)
    rwkv_w2 = nrm((N_RWKV, D_DECAY_LORA, D), 0.5 * D_DECAY_LORA ** -0.5)
    rwkv_a0 = nrm((N_RWKV, D), 0.1)
    rwkv_a1 = nrm((N_RWKV, D, D_AAA_LORA), D ** -0.5)
    rwkv_a2 = nrm((N_RWKV, D_AAA_LORA, D), 0.5 * D_AAA_LORA ** -0.5)
    rwkv_v0 = nrm((N_RWKV - 1, D), 0.1)
    rwkv_v1 = nrm((N_RWKV - 1, D, D_MV_LORA), D ** -0.5)
    rwkv_v2 = nrm((N_RWKV - 1, D_MV_LORA, D), 0.5 * D_MV_LORA ** -0.5)
    rwkv_g1 = nrm((N_RWKV, D, D_GATE_LORA), D ** -0.5)
    rwkv_g2 = nrm((N_RWKV, D_GATE_LORA, D), D_GATE_LORA ** -0.5)
    rwkv_k_k = 0.85 + nrm((N_RWKV, D), 0.05)
    rwkv_k_a = 1.0 + nrm((N_RWKV, D), 0.05)
    rwkv_r_k = nrm((N_RWKV, RWKV_HEADS, HEAD_SIZE), 0.1)
    rwkv_ln_w = 1.0 + nrm((N_RWKV, D), 0.05)
    rwkv_ln_b = nrm((N_RWKV, D), 0.02)
    final_gain = 1.0 + nrm((D,), 0.02)
    return {'x_prompt': x_prompt, 'x_sample': x_sample,
            'state_lru_h': state_lru_h, 'state_lru_conv': state_lru_conv,
            'state_rwkv_shift': state_rwkv_shift, 'state_rwkv_wkv': state_rwkv_wkv,
            'c_prompt': c_prompt, 'c_sample': c_sample,
            'ada_w': ada_w, 'ada_b': ada_b, 'ffn_w_in': ffn_w_in, 'ffn_w_out': ffn_w_out,
            'lru_w_in': lru_w_in, 'lru_conv_w': lru_conv_w, 'lru_conv_b': lru_conv_b,
            'lru_gate_w': lru_gate_w, 'lru_gate_b': lru_gate_b, 'lru_lambda': lru_lambda, 'lru_w_out': lru_w_out,
            'rwkv_mu': rwkv_mu, 'rwkv_w_rkv': rwkv_w_rkv, 'rwkv_w_o': rwkv_w_o,
            'rwkv_w0': rwkv_w0, 'rwkv_w1': rwkv_w1, 'rwkv_w2': rwkv_w2,
            'rwkv_a0': rwkv_a0, 'rwkv_a1': rwkv_a1, 'rwkv_a2': rwkv_a2,
            'rwkv_v0': rwkv_v0, 'rwkv_v1': rwkv_v1, 'rwkv_v2': rwkv_v2,
            'rwkv_g1': rwkv_g1, 'rwkv_g2': rwkv_g2, 'rwkv_k_k': rwkv_k_k, 'rwkv_k_a': rwkv_k_a,
            'rwkv_r_k': rwkv_r_k, 'rwkv_ln_w': rwkv_ln_w, 'rwkv_ln_b': rwkv_ln_b,
            'final_gain': final_gain}


def reference(x_prompt, x_sample, state_lru_h, state_lru_conv, state_rwkv_shift, state_rwkv_wkv,
              c_prompt, c_sample, ada_w, ada_b, ffn_w_in, ffn_w_out,
              lru_w_in, lru_conv_w, lru_conv_b, lru_gate_w, lru_gate_b, lru_lambda, lru_w_out,
              rwkv_mu, rwkv_w_rkv, rwkv_w_o, rwkv_w0, rwkv_w1, rwkv_w2, rwkv_a0, rwkv_a1, rwkv_a2,
              rwkv_v0, rwkv_v1, rwkv_v2, rwkv_g1, rwkv_g2, rwkv_k_k, rwkv_k_a, rwkv_r_k,
              rwkv_ln_w, rwkv_ln_b, final_gain):
    P = dict(ada_w=ada_w, ada_b=ada_b, ffn_w_in=ffn_w_in, ffn_w_out=ffn_w_out,
             lru_w_in=lru_w_in, lru_conv_w=lru_conv_w, lru_conv_b=lru_conv_b, lru_gate_w=lru_gate_w,
             lru_gate_b=lru_gate_b, lru_lambda=lru_lambda, lru_w_out=lru_w_out,
             rwkv_mu=rwkv_mu, rwkv_w_rkv=rwkv_w_rkv, rwkv_w_o=rwkv_w_o, rwkv_w0=rwkv_w0, rwkv_w1=rwkv_w1,
             rwkv_w2=rwkv_w2, rwkv_a0=rwkv_a0, rwkv_a1=rwkv_a1, rwkv_a2=rwkv_a2, rwkv_v0=rwkv_v0,
             rwkv_v1=rwkv_v1, rwkv_v2=rwkv_v2, rwkv_g1=rwkv_g1, rwkv_g2=rwkv_g2, rwkv_k_k=rwkv_k_k,
             rwkv_k_a=rwkv_k_a, rwkv_r_k=rwkv_r_k, rwkv_ln_w=rwkv_ln_w, rwkv_ln_b=rwkv_ln_b,
             final_gain=final_gain)
    B = x_prompt.shape[0]
    h0 = jnp.zeros((N_LRU, B, D_RNN), jnp.float32)
    conv0 = jnp.zeros((N_LRU, B, CONV_W - 1, D_RNN), jnp.float32)
    shift0 = jnp.zeros((N_RWKV, B, D_MODEL), jnp.float32)
    wkv0 = jnp.zeros((N_RWKV, B, RWKV_HEADS, HEAD_SIZE, HEAD_SIZE), jnp.float32)
    y_prompt, p_lru_h, p_lru_conv, p_rwkv_shift, p_rwkv_wkv = trunk(x_prompt, c_prompt, h0, conv0, shift0, wkv0, P)
    y_sample, s_lru_h, s_lru_conv, s_rwkv_shift, s_rwkv_wkv = trunk(
        x_sample, c_sample, state_lru_h, state_lru_conv, state_rwkv_shift, state_rwkv_wkv, P)
    return (y_prompt, y_sample, p_lru_h, p_lru_conv, p_rwkv_shift, p_rwkv_wkv,
            s_lru_h, s_lru_conv, s_rwkv_shift, s_rwkv_wkv)
```

```cpp
#include <hip/hip_runtime.h>
#include <hip/hip_cooperative_groups.h>
#include <cstdio>
#include <cstdint>
namespace cg = cooperative_groups;

#ifndef PROBE
#define PROBE 0
#endif
#ifndef MK_COOP
#define MK_COOP 1
#endif

#define LAS __attribute__((address_space(3)))
#define GAS __attribute__((address_space(1)))
typedef unsigned short bf16_t;
typedef short bf16x8 __attribute__((ext_vector_type(8)));
typedef float f32x4 __attribute__((ext_vector_type(4)));
typedef float f32x2 __attribute__((ext_vector_type(2)));
typedef unsigned u32x2 __attribute__((ext_vector_type(2)));
typedef unsigned u32x4 __attribute__((ext_vector_type(4)));

constexpr int D = 1024, MP = 16384, MS = 1024, MT = MP + MS;
constexpr int DFF = 2816, NMODC = 9 * D, NCB = 136;
constexpr int LDS_BYTES = 144 * 1024;

constexpr size_t MD4 = (size_t)MT * D * 4, MD2 = MD4 / 2;
constexpr size_t SZ_WFI1 = (size_t)5632 * 1024 * 2, SZ_WFO1 = (size_t)1024 * 2816 * 2, SZ_W1M = (size_t)1024 * 1024 * 2;
constexpr size_t SZ_WLG1 = (size_t)4 * 512 * 256 * 2, SZ_WL1 = (size_t)4 * 256 * 1024 * 2, SZ_WL2 = (size_t)4096 * 384 * 2;
constexpr size_t O_WFI = 0;
constexpr size_t O_WFO = O_WFI + 8 * SZ_WFI1;
constexpr size_t O_WLI = O_WFO + 8 * SZ_WFO1;
constexpr size_t O_WLG = O_WLI + 2 * 2 * SZ_W1M;
constexpr size_t O_WLO = O_WLG + 2 * SZ_WLG1;
constexpr size_t O_WRKV = O_WLO + 2 * SZ_W1M;
constexpr size_t O_WO = O_WRKV + 6 * SZ_W1M;
constexpr size_t O_WL1 = O_WO + 2 * SZ_W1M;
constexpr size_t O_WL2 = O_WL1 + 2 * SZ_WL1;
constexpr size_t O_XW = O_WL2 + 2 * SZ_WL2;
constexpr size_t O_HB = O_XW + MD4;
constexpr size_t O_VF = O_HB + MD2;
constexpr size_t O_MOD = O_VF + MD2;
constexpr size_t SZ_MOD = (size_t)NCB * 4 * NMODC * 4;
constexpr size_t O_CS = O_MOD + SZ_MOD;
constexpr size_t O_AGG = O_CS + (size_t)256 * 1024 * 2;
constexpr size_t O_U = O_AGG + (size_t)8 * 16 * 1024 * 8;
constexpr size_t O_ADAT = O_U;
constexpr size_t O_ACT = O_U;
constexpr size_t O_GG = O_U, O_REC = O_U + MD2, O_XC = O_REC + MD4, O_AA = O_XC + MD2, O_UU = O_AA + MD4;
constexpr size_t O_XM = O_U, O_WD = O_U, O_AS = O_U + MD4, O_GS = O_U + 2 * MD4;
constexpr size_t O_R = O_U + 6 * MD2, O_K = O_R + MD2, O_V = O_K + MD2, O_ACAT = O_V + MD4;
constexpr size_t O_TAB = O_ACAT + (size_t)MT * 384 * 2;
constexpr size_t O_BAR = O_TAB + 512;
constexpr size_t O_PART = O_BAR + 16384;
constexpr size_t PART_SLAB = (size_t)MS * D * 4;
constexpr size_t O_XB = O_PART + 5 * PART_SLAB;
constexpr size_t WS_END = O_XB + (size_t)128 * 2 * 8 * 32 * 8;
static_assert(WS_END <= (size_t)738197504, "workspace too large");
static_assert(O_UU + MD4 <= O_ACAT, "lru overlay");

constexpr size_t OUT_Y = 0;
constexpr size_t OUT_P_H = (size_t)MT * D;
constexpr size_t OUT_P_CONV = OUT_P_H + 2 * 8 * 1024;
constexpr size_t OUT_P_SHIFT = OUT_P_CONV + 2 * 8 * 3 * 1024;
constexpr size_t OUT_P_WKV = OUT_P_SHIFT + 2 * 8 * 1024;
constexpr size_t OUT_S_H = OUT_P_WKV + (size_t)2 * 8 * 16 * 4096;
constexpr size_t OUT_S_CONV = OUT_S_H + 2 * 128 * 1024;
constexpr size_t OUT_S_SHIFT = OUT_S_CONV + 2 * 128 * 3 * 1024;
constexpr size_t OUT_S_WKV = OUT_S_SHIFT + 2 * 128 * 1024;

struct Args { const float* in[39]; float* out; unsigned char* ws; int lo, hi; };

__device__ __forceinline__ unsigned cvt_pk_bf16(float lo, float hi) { unsigned r; asm volatile("v_cvt_pk_bf16_f32 %0, %1, %2" : "=v"(r) : "v"(lo), "v"(hi)); return r; }
__device__ __forceinline__ float bf_lo(unsigned u) { return __uint_as_float(u << 16); }
__device__ __forceinline__ float bf_hi(unsigned u) { return __uint_as_float(u & 0xffff0000u); }
__device__ __forceinline__ float frcp(float x) { return __builtin_amdgcn_rcpf(x); }
__device__ __forceinline__ float fsigmoid(float x) { return frcp(1.f + __expf(-x)); }
__device__ __forceinline__ float ftanh(float x) { return 1.f - 2.f * frcp(1.f + __expf(2.f * x)); }
__device__ __forceinline__ float fsilu(float x) { return x * fsigmoid(x); }
__device__ __forceinline__ float fgelu(float x) { return 0.5f * x * (1.f + ftanh(0.7978845608028654f * (x + 0.044715f * x * x * x))); }
__device__ __forceinline__ int cb_of(int row) { return row < MP ? (row >> 11) : 8 + ((row - MP) >> 3); }
template <int CTRL> __device__ __forceinline__ float dpp_f(float v) { return __int_as_float(__builtin_amdgcn_update_dpp(0, __float_as_int(v), CTRL, 0xF, 0xF, true)); }
__device__ __forceinline__ float sum8(float v) {
    v += dpp_f<0xB1>(v);
    v += dpp_f<0x4E>(v);
    v += dpp_f<0x141>(v);
    return v;
}

__device__ __forceinline__ float row16_sum(float v) {
    v += dpp_f<0xB1>(v); v += dpp_f<0x4E>(v); v += dpp_f<0x141>(v); v += dpp_f<0x140>(v); return v;
}
__device__ __forceinline__ float xor_shfl(float v, int lane, int o) { return __int_as_float(__builtin_amdgcn_ds_bpermute((lane ^ o) << 2, __float_as_int(v))); }
__device__ __forceinline__ float wave_sum(float v, int lane) { v = row16_sum(v); v += xor_shfl(v, lane, 16); v += xor_shfl(v, lane, 32); return v; }
__device__ __forceinline__ float half_sum(float v, int lane) { v = row16_sum(v); v += xor_shfl(v, lane, 16); return v; }

constexpr int BM = 256, BK = 64, HALF = 128, HTB = HALF * BK * 2, NXCD = 8, WGM = 8;
__device__ __forceinline__ int lds_byte(int r, int c) { const int st = (r >> 4) * 2 + (c >> 5), rr = r & 15, cc = c & 31, ob = rr * 64 + cc * 2; return st * 1024 + (ob ^ (((ob >> 9) & 1) << 5)); }
__device__ __forceinline__ void stage_rc(int b, int& R, int& C) { const int st = b / 1024, sb = b % 1024, swz = sb ^ (((sb >> 9) & 1) << 5); R = (st >> 1) * 16 + swz / 64; C = (st & 1) * 32 + (swz % 64) / 2; }

__device__ __forceinline__ int perm32(int rho) { const int n = rho >> 4, i = rho & 15; return 8 * (i >> 2) + 4 * n + (i & 3); }
struct Unit { const char* a; const char* b; int pm, pn, gi, nt; };
__device__ __forceinline__ void tile_of(int wgid, int nM, int nN, int& pm, int& pn) {
    const int nwg = nM * nN;
    { const int q = nwg / NXCD, r = nwg % NXCD, xcd = wgid % NXCD, off = wgid / NXCD; wgid = (xcd < r ? xcd * (q + 1) : r * (q + 1) + (xcd - r) * q) + off; }
    const int nig = WGM * nN, gid = wgid / nig, fm = gid * WGM, gsz = (nM - fm) < WGM ? (nM - fm) : WGM;
    pm = fm + ((wgid % nig) % gsz); pn = (wgid % nig) / gsz;
}
struct Sched1 {
    const char* A; const char* B; int nM, nN; size_t tA, tB; int nt, G, c;
    __device__ __forceinline__ bool next(int i, Unit& u) const {
        const long L = (long)i * G + c; if (L >= (long)nM * nN) return false;
        tile_of((int)L, nM, nN, u.pm, u.pn); u.gi = 0; u.nt = nt; u.a = A + (size_t)u.pm * tA; u.b = B + (size_t)u.pn * tB; return true;
    }
};
struct SchedResid {
    const char* A; const char* B; int ldk, S, G, c;
    __device__ __forceinline__ bool next(int i, Unit& u) const {
        const int nsplit = 16 * S;
        long L = (long)i * G + c;
        if (G == 256 && c < nsplit) { if (i == 0) L = 256 + c; else if (i == 1) L = c; else return false; }
        if (L < 256) { tile_of((int)L, 64, 4, u.pm, u.pn); u.gi = 0; u.nt = ldk / 64; u.a = A + (size_t)u.pm * 512 * ldk; u.b = B + (size_t)u.pn * 512 * ldk; return true; }
        const int idx = (int)L - 256; if (idx >= nsplit) return false;
        const int tile = idx / S, ks = idx % S; u.pm = 64 + (tile >> 2); u.pn = tile & 3; u.gi = 1 + ks;
        const int pairs = ldk / 128, base = 2 * (pairs / S), rem = pairs % S, start = ks * base + 2 * (ks < rem ? ks : rem);
        u.nt = base + (ks < rem ? 2 : 0);
        u.a = A + (size_t)u.pm * 512 * ldk + (size_t)start * 128; u.b = B + (size_t)u.pn * 512 * ldk + (size_t)start * 128; return true;
    }
};
struct SchedRkv {
    const char* XM; const char* WR; const char* WL; int ng; int G, c;
    __device__ __forceinline__ bool next(int i, Unit& u) const {
        const long L = (long)i * G + c; constexpr int nM = MT / 256, BIG = nM * 4;
        if (L >= 3 * BIG + (ng - 3) * nM) return false;
        int gi, l, nN;
        if (L < 3 * BIG) { gi = (int)L / BIG; l = (int)L % BIG; nN = 4; } else { const int r = (int)L - 3 * BIG; gi = 3 + r / nM; l = r % nM; nN = 1; }
        tile_of(l, nM, nN, u.pm, u.pn); u.gi = gi; u.nt = 16;
        const int ai = gi < 3 ? gi : (gi == 6 ? 2 : gi);
        u.a = XM + (size_t)ai * MD2 + (size_t)u.pm * (256 * 1024 * 2);
        u.b = (gi < 3 ? WR + (size_t)gi * SZ_W1M : WL + (size_t)(gi - 3) * (256 * 1024 * 2)) + (size_t)u.pn * (256 * 1024 * 2);
        return true;
    }
};
struct SchedGate {
    const char* XC; const char* WG; int G, c;
    __device__ __forceinline__ bool next(int i, Unit& u) const {
        const long L = (long)i * G + c; constexpr int nM = MT / 256, PER = nM * 2;
        if (L >= 4 * PER) return false;
        const int gi = (int)L / PER, l = (int)L % PER;
        tile_of(l, nM, 2, u.pm, u.pn); u.gi = gi; u.nt = 4;
        u.a = XC + (size_t)gi * 512 + (size_t)u.pm * (256 * 1024 * 2);
        u.b = WG + (size_t)gi * (512 * 256 * 2) + (size_t)u.pn * (256 * 256 * 2);
        return true;
    }
};

template <bool PERM = false, class Epi, class Sched>
__device__ __forceinline__ void gemm_phase(LAS unsigned char* lds, const int tid, const int lda, const int ldb, const int K, const Sched& S, const Epi& E) {
    const int wid = __builtin_amdgcn_readfirstlane(tid >> 6), lane = tid & 63, wr = wid >> 2, wc = wid & 3, fr = lane & 15, fq = lane >> 4;
    unsigned voffA[2], voffB[2];
#pragma unroll
    for (int i = 0; i < 2; ++i) { int R, C; stage_rc(tid * 16 + i * 8192, R, C); const int Rb = PERM ? ((R & ~31) + perm32(R & 31)) : R; voffA[i] = (unsigned)(R * lda + C) * 2u; voffB[i] = (unsigned)(Rb * ldb + C) * 2u; }
    const size_t kstep = (size_t)(BK * 2);
    const size_t hstepA = (size_t)HALF * lda * 2, hstepB = (size_t)HALF * ldb * 2;
    const unsigned ldsw = (unsigned)wid * 1024u;
    const int aoff = lds_byte(wr * 64 + fr, fq * 8), boff = lds_byte(wc * 32 + fr, fq * 8);
#define PG8_SA(b, h) (((b) * 2 + (h)) * HTB)
#define PG8_SB(b, h) ((4 + (b) * 2 + (h)) * HTB)
#define PG8_STAGE(bufoff, gbase, voff) do { _Pragma("unroll") for (int _i = 0; _i < 2; ++_i) \
        __builtin_amdgcn_global_load_lds((const unsigned*)((const char*)(gbase) + (voff)[_i]), (LAS unsigned*)(lds + (bufoff) + ldsw + _i * 8192), 16, 0, 0); } while (0)
#define PG8_LDA(dst, b, h) do { _Pragma("unroll") for (int m = 0; m < 4; ++m) _Pragma("unroll") for (int k = 0; k < 2; ++k) dst[m][k] = *(const LAS bf16x8*)(lds + PG8_SA(b, h) + aoff + m * 2048 + k * 1024); } while (0)
#define PG8_LDB(dst, b, h) do { _Pragma("unroll") for (int n = 0; n < 2; ++n) _Pragma("unroll") for (int k = 0; k < 2; ++k) dst[n][k] = *(const LAS bf16x8*)(lds + PG8_SB(b, h) + boff + n * 2048 + k * 1024); } while (0)
#define PG8_MMA(ai, bj, At, Bt) do { __builtin_amdgcn_s_setprio(1); _Pragma("unroll") for (int m = 0; m < 4; ++m) _Pragma("unroll") for (int n = 0; n < 2; ++n) _Pragma("unroll") for (int k = 0; k < 2; ++k) \
        acc[ai][bj][m][n] = __builtin_amdgcn_mfma_f32_16x16x32_bf16(Bt[n][k], At[m][k], acc[ai][bj][m][n], 0, 0, 0); __builtin_amdgcn_s_setprio(0); } while (0)
#define PG8_WAIT_V(n) asm volatile("s_waitcnt vmcnt(" #n ")" ::: "memory")
#define PG8_WAIT_L(n) asm volatile("s_waitcnt lgkmcnt(" #n ")" ::: "memory")
#define PG8_BAR __builtin_amdgcn_s_barrier()
#define PG8_SCHED __builtin_amdgcn_sched_barrier(0)
    Unit cur, nxt; int ui = 0;
    if (!S.next(0, cur)) return;
    f32x4 acc[2][2][4][2];
#pragma unroll
    for (int a = 0; a < 2; ++a)
#pragma unroll
        for (int b = 0; b < 2; ++b)
#pragma unroll
            for (int m = 0; m < 4; ++m)
#pragma unroll
                for (int n = 0; n < 2; ++n) acc[a][b][m][n] = (f32x4){0.f, 0.f, 0.f, 0.f};
    bf16x8 At[4][2], B0[2][2], B1[2][2];
    const char* cA = cur.a; const char* cB = cur.b;
    PG8_STAGE(PG8_SB(0, 0), cB, voffB); PG8_STAGE(PG8_SA(0, 0), cA, voffA); PG8_STAGE(PG8_SB(0, 1), cB + hstepB, voffB); PG8_STAGE(PG8_SA(0, 1), cA + hstepA, voffA);
    if (wr == 1) PG8_BAR;
    PG8_WAIT_V(4); PG8_BAR;
    PG8_STAGE(PG8_SB(1, 0), cB + kstep, voffB); PG8_STAGE(PG8_SA(1, 0), cA + kstep, voffA); PG8_STAGE(PG8_SB(1, 1), cB + hstepB + kstep, voffB);
    PG8_WAIT_V(6); PG8_BAR;
    for (;;) {
        const bool has_next = S.next(ui + 1, nxt);
        const char* nA = has_next ? nxt.a : cA; const char* nB = has_next ? nxt.b : cB;
        const int nt = cur.nt;
        for (int t = 0; t < nt; t += 2) {
            const bool last = (t == nt - 2);
            const char* a1 = cA + (size_t)(t + 1) * kstep;
            const char* a2 = last ? nA : cA + (size_t)(t + 2) * kstep; const char* b2 = last ? nB : cB + (size_t)(t + 2) * kstep;
            const char* a3 = a2 + kstep; const char* b3 = b2 + kstep;
            PG8_LDB(B0, 0, 0); PG8_SCHED; PG8_LDA(At, 0, 0); PG8_STAGE(PG8_SA(1, 1), a1 + hstepA, voffA);
            PG8_WAIT_L(8); PG8_BAR; PG8_WAIT_L(0); PG8_MMA(0, 0, At, B0); PG8_BAR; PG8_SCHED;
            PG8_LDB(B1, 0, 1); PG8_STAGE(PG8_SB(0, 0), b2, voffB);
            PG8_BAR; PG8_WAIT_L(0); PG8_MMA(0, 1, At, B1); PG8_BAR;
            PG8_LDA(At, 0, 1); PG8_STAGE(PG8_SA(0, 0), a2, voffA);
            PG8_BAR; PG8_WAIT_L(0); PG8_MMA(1, 0, At, B0); PG8_BAR; PG8_SCHED;
            PG8_STAGE(PG8_SB(0, 1), b2 + hstepB, voffB);
            PG8_WAIT_V(6); PG8_BAR; PG8_MMA(1, 1, At, B1); PG8_BAR;
            PG8_LDB(B0, 1, 0); PG8_SCHED; PG8_LDA(At, 1, 0); PG8_STAGE(PG8_SA(0, 1), a2 + hstepA, voffA);
            PG8_WAIT_L(8); PG8_BAR; PG8_WAIT_L(0); PG8_MMA(0, 0, At, B0); PG8_BAR; PG8_SCHED;
            PG8_LDB(B1, 1, 1); PG8_STAGE(PG8_SB(1, 0), b3, voffB);
            PG8_BAR; PG8_WAIT_L(0); PG8_MMA(0, 1, At, B1); PG8_BAR;
            PG8_LDA(At, 1, 1); PG8_STAGE(PG8_SA(1, 0), a3, voffA);
            PG8_BAR; PG8_WAIT_L(0); PG8_MMA(1, 0, At, B0); PG8_BAR; PG8_SCHED;
            PG8_STAGE(PG8_SB(1, 1), b3 + hstepB, voffB);
            PG8_WAIT_V(6); PG8_BAR; PG8_MMA(1, 1, At, B1); PG8_BAR;
        }
        E(acc, cur, wr, wc, fr, fq);
        if (!has_next) break;
#pragma unroll
        for (int a = 0; a < 2; ++a)
#pragma unroll
            for (int b = 0; b < 2; ++b)
#pragma unroll
                for (int m = 0; m < 4; ++m)
#pragma unroll
                    for (int n = 0; n < 2; ++n) acc[a][b][m][n] = (f32x4){0.f, 0.f, 0.f, 0.f};
        cur = nxt; cA = nA; cB = nB; ++ui;
    }
    PG8_WAIT_V(0);
    if (wr == 0) PG8_BAR;
    PG8_BAR;
#undef PG8_SA
#undef PG8_SB
#undef PG8_STAGE
#undef PG8_LDA
#undef PG8_LDB
#undef PG8_MMA
#undef PG8_WAIT_V
#undef PG8_WAIT_L
#undef PG8_BAR
#undef PG8_SCHED
}

typedef f32x4 AccT[2][2][4][2];
#define EPI_LOOP_ROWS for (int ai = 0; ai < 2; ++ai) for (int m = 0; m < 4; ++m)
#define EPI_LOOP_COLS for (int bj = 0; bj < 2; ++bj) for (int n = 0; n < 2; ++n)

struct EpiMod {
    float* MOD; const float* bias;
    __device__ __forceinline__ void operator()(const AccT& acc, const Unit& u, int wr, int wc, int fr, int fq) const {
        const int row0 = wr * 64 + fr, col0 = u.pn * 256 + wc * 32 + 4 * fq;
#pragma unroll
        EPI_LOOP_ROWS { const int row = row0 + ai * 128 + m * 16; if (row < NCB) {
#pragma unroll
            EPI_LOOP_COLS { const int col = col0 + bj * 128 + n * 16; *(f32x4*)(MOD + (size_t)row * (4 * NMODC) + col) = acc[ai][bj][m][n] + *(const f32x4*)(bias + col); } } }
    }
};
struct EpiResid {
    float* X; const float* XR; float* PART; const float* modg; float coef;
    __device__ __forceinline__ void operator()(const AccT& acc, const Unit& u, int wr, int wc, int fr, int fq) const {
        const int row0 = u.pm * 256 + wr * 64 + fr, col0 = u.pn * 256 + wc * 32 + 4 * fq;
#pragma unroll
        EPI_LOOP_ROWS { const int row = row0 + ai * 128 + m * 16; const float* gp = modg + (size_t)cb_of(row) * (4 * NMODC) + col0;
            float* xp = u.gi == 0 ? X + (size_t)row * D + col0 : PART + (size_t)(u.gi - 1) * (MS * D) + (size_t)(row - MP) * D + col0;
#pragma unroll
            EPI_LOOP_COLS { const int o = bj * 128 + n * 16; const f32x4 g = *(const f32x4*)(gp + o); f32x4 d = (g + 1.f) * coef * acc[ai][bj][m][n];
                if (u.gi == 0) d += *(const f32x4*)(XR + (size_t)row * D + col0 + o);
                *(f32x4*)(xp + o) = d; } }
    }
};
struct EpiSwiglu {
    bf16_t* ACT;
    __device__ __forceinline__ void operator()(const AccT& acc, const Unit& u, int wr, int wc, int fr, int fq) const {
        const int row0 = u.pm * 256 + wr * 64 + fr, col0 = u.pn * 128 + wc * 32 + 8 * fq;
#pragma unroll
        EPI_LOOP_ROWS { bf16_t* op = ACT + (size_t)(row0 + ai * 128 + m * 16) * DFF + col0;
            const f32x4 g0 = acc[ai][0][m][0], v0 = acc[ai][1][m][0], g1 = acc[ai][0][m][1], v1 = acc[ai][1][m][1];
            u32x4 o; o.x = cvt_pk_bf16(fsilu(g0.x) * v0.x, fsilu(g0.y) * v0.y); o.y = cvt_pk_bf16(fsilu(g0.z) * v0.z, fsilu(g0.w) * v0.w);
            o.z = cvt_pk_bf16(fsilu(g1.x) * v1.x, fsilu(g1.y) * v1.y); o.w = cvt_pk_bf16(fsilu(g1.z) * v1.z, fsilu(g1.w) * v1.w);
            *(u32x4*)op = o; }
    }
};
struct EpiLruIn {
    bf16_t* GG; float* REC;
    __device__ __forceinline__ void operator()(const AccT& acc, const Unit& u, int wr, int wc, int fr, int fq) const {
        const int row0 = u.pm * 256 + wr * 64 + fr, col0 = (u.pn & 3) * 256 + wc * 32 + 4 * fq;
        if (u.pn < 4) {
#pragma unroll
            EPI_LOOP_ROWS { bf16_t* op = GG + (size_t)(row0 + ai * 128 + m * 16) * D + col0;
#pragma unroll
                EPI_LOOP_COLS { const f32x4 v = acc[ai][bj][m][n]; u32x2 o; o.x = cvt_pk_bf16(fgelu(v.x), fgelu(v.y)); o.y = cvt_pk_bf16(fgelu(v.z), fgelu(v.w)); *(u32x2*)(op + bj * 128 + n * 16) = o; } }
        } else {
#pragma unroll
            EPI_LOOP_ROWS { float* op = REC + (size_t)(row0 + ai * 128 + m * 16) * D + col0;
#pragma unroll
                EPI_LOOP_COLS *(f32x4*)(op + bj * 128 + n * 16) = acc[ai][bj][m][n]; }
        }
    }
};
struct EpiLruGate {
    float* AA; float* UU; const bf16_t* XC; const float* gate_b; const float* lam;
    __device__ __forceinline__ void operator()(const AccT& acc, const Unit& u, int wr, int wc, int fr, int fq) const {
        const int row0 = u.pm * 256 + wr * 64 + fr, cl = u.pn * 128 + wc * 32 + 4 * fq, ch0 = u.gi * 256 + cl;
#pragma unroll
        for (int n = 0; n < 2; ++n) {
            const f32x4 br = *(const f32x4*)(gate_b + u.gi * 512 + cl + n * 16), bi = *(const f32x4*)(gate_b + u.gi * 512 + 256 + cl + n * 16);
            const f32x4 lm = *(const f32x4*)(lam + ch0 + n * 16); f32x4 ls;
#pragma unroll
            for (int e = 0; e < 4; ++e) { const float x = __expf(-lm[e]); ls[e] = -8.f * x * (1.f - x * (0.5f - x * (0.33333333f - 0.25f * x))); }
#pragma unroll
            EPI_LOOP_ROWS { const size_t ro = (size_t)(row0 + ai * 128 + m * 16) * D + ch0 + n * 16;
                const u32x2 xb = *(const u32x2*)(XC + ro);
                const f32x4 xv = (f32x4){bf_lo(xb.x), bf_hi(xb.x), bf_lo(xb.y), bf_hi(xb.y)};
                f32x4 av, uv;
#pragma unroll
                for (int e = 0; e < 4; ++e) { const float r = fsigmoid(acc[ai][0][m][n][e] + br[e]), ig = fsigmoid(acc[ai][1][m][n][e] + bi[e]);
                    const float a1 = __expf(r * ls[e]); av[e] = a1; uv[e] = sqrtf(fmaxf(1.f - a1 * a1, 0.f)) * ig * xv[e]; }
                *(f32x4*)(AA + ro) = av; *(f32x4*)(UU + ro) = uv; } }
    }
};
struct EpiRkv {
    bf16_t* R; bf16_t* Kb; float* V; bf16_t* VF; bf16_t* ACAT; int write_vf;
    __device__ __forceinline__ void operator()(const AccT& acc, const Unit& u, int wr, int wc, int fr, int fq) const {
        const int row0 = u.pm * 256 + wr * 64 + fr, col0 = u.pn * 256 + wc * 32 + 4 * fq;
        if (u.gi < 2) { bf16_t* O = u.gi == 0 ? R : Kb;
#pragma unroll
            EPI_LOOP_ROWS { bf16_t* op = O + (size_t)(row0 + ai * 128 + m * 16) * D + col0;
#pragma unroll
                EPI_LOOP_COLS { const f32x4 v = acc[ai][bj][m][n]; u32x2 o; o.x = cvt_pk_bf16(v.x, v.y); o.y = cvt_pk_bf16(v.z, v.w); *(u32x2*)(op + bj * 128 + n * 16) = o; } }
        } else if (u.gi == 2) {
#pragma unroll
            EPI_LOOP_ROWS { const size_t ro = (size_t)(row0 + ai * 128 + m * 16) * D + col0;
#pragma unroll
                EPI_LOOP_COLS { const f32x4 v = acc[ai][bj][m][n]; *(f32x4*)(V + ro + bj * 128 + n * 16) = v;
                    if (write_vf) { u32x2 o; o.x = cvt_pk_bf16(v.x, v.y); o.y = cvt_pk_bf16(v.z, v.w); *(u32x2*)(VF + ro + bj * 128 + n * 16) = o; } } }
        } else {
            const int nv = u.gi == 5 ? 160 : (u.gi == 6 ? 32 : 64), cbase = u.gi == 3 ? 0 : (u.gi == 4 ? 64 : (u.gi == 5 ? 128 : 288));
#pragma unroll
            EPI_LOOP_ROWS { bf16_t* op = ACAT + (size_t)(row0 + ai * 128 + m * 16) * 384 + cbase;
#pragma unroll
                EPI_LOOP_COLS { const int col = col0 + bj * 128 + n * 16; if (col < nv) { f32x4 v = acc[ai][bj][m][n];
                    if (u.gi == 3) { v.x = ftanh(v.x); v.y = ftanh(v.y); v.z = ftanh(v.z); v.w = ftanh(v.w); }
                    else if (u.gi == 5) { v.x = fsigmoid(v.x); v.y = fsigmoid(v.y); v.z = fsigmoid(v.z); v.w = fsigmoid(v.w); }
                    u32x2 o; o.x = cvt_pk_bf16(v.x, v.y); o.y = cvt_pk_bf16(v.z, v.w); *(u32x2*)(op + col) = o; } } }
        }
    }
};
struct EpiLora2 {
    float* WD; float* AS; float* GS; float* V; const bf16_t* VF; const float* w0; const float* a0; const float* v0; int skipv;
    __device__ __forceinline__ void operator()(const AccT& acc, const Unit& u, int wr, int wc, int fr, int fq) const {
        const int sec = u.pn >> 2, row0 = u.pm * 256 + wr * 64 + fr, col0 = (u.pn & 3) * 256 + wc * 32 + 4 * fq;
#pragma unroll
        EPI_LOOP_ROWS { const size_t ro = (size_t)(row0 + ai * 128 + m * 16) * D + col0;
#pragma unroll
            EPI_LOOP_COLS { const int o = bj * 128 + n * 16; const f32x4 v = acc[ai][bj][m][n]; f32x4 r;
                if (sec == 0) { const f32x4 b = *(const f32x4*)(w0 + col0 + o);
#pragma unroll
                    for (int e = 0; e < 4; ++e) r[e] = __expf(-0.6065306597f * fsigmoid(b[e] + v[e]));
                    *(f32x4*)(WD + ro + o) = r;
                } else if (sec == 1) { const f32x4 b = *(const f32x4*)(a0 + col0 + o);
#pragma unroll
                    for (int e = 0; e < 4; ++e) r[e] = fsigmoid(b[e] + v[e]);
                    *(f32x4*)(AS + ro + o) = r;
                } else if (sec == 2) { *(f32x4*)(GS + ro + o) = v;
                } else if (!skipv) { const f32x4 b = *(const f32x4*)(v0 + col0 + o); const f32x4 vr = *(const f32x4*)(V + ro + o); const u32x2 fb = *(const u32x2*)(VF + ro + o);
                    const float vf[4] = {bf_lo(fb.x), bf_hi(fb.x), bf_lo(fb.y), bf_hi(fb.y)};
#pragma unroll
                    for (int e = 0; e < 4; ++e) r[e] = vr[e] + (vf[e] - vr[e]) * fsigmoid(b[e] + v[e]);
                    *(f32x4*)(V + ro + o) = r; } } }
    }
};


#define XB_TMO      128
#define XB_XCNT(j)  (256  + 64 * (j))
#define XB_XSUB(j)  (1280 + 64 * (j))
#define XB_XGEN(j)  (2304 + 64 * (j))
#define XB_TOP      3328
#define XB_TOPGEN   3392
#define XCD_BAR_WORDS 3456
#define XB_SPIN_CAP (1u << 18)
__device__ __forceinline__ unsigned xb_ld(unsigned* p)              { return __hip_atomic_load(p, __ATOMIC_RELAXED, __HIP_MEMORY_SCOPE_AGENT); }
__device__ __forceinline__ unsigned xb_add(unsigned* p, unsigned v) { return __hip_atomic_fetch_add(p, v, __ATOMIC_RELAXED, __HIP_MEMORY_SCOPE_AGENT); }
__device__ __forceinline__ unsigned xb_xcc_id() { return (unsigned)__builtin_amdgcn_s_getreg((3 << 11) | 20) & 0xFu; }
#define XB_SPIN(cond, bar) do { unsigned _sp = 0; while (cond) { __builtin_amdgcn_s_sleep(1); \
    if ((++_sp & 255u) == 0u) { if (xb_ld(&(bar)[XB_TMO])) break; if (_sp > XB_SPIN_CAP) { atomicAdd(&(bar)[XB_TMO], 1u); break; } } } } while (0)
struct XcdBarrier { unsigned* bar; unsigned x; volatile LAS unsigned* st; };
__device__ __forceinline__ XcdBarrier xcd_barrier_post(unsigned* bar, volatile LAS unsigned* st) {
    XcdBarrier b; b.bar = bar; b.x = xb_xcc_id(); b.st = st;
    if (threadIdx.x == 0) (void)xb_add(&bar[XB_XCNT(b.x)], 1u);
    return b;
}
__device__ __forceinline__ void xcd_barrier_complete(unsigned* bar, unsigned x, unsigned& nloc, unsigned& nx) {
    const unsigned G = gridDim.x * gridDim.y * gridDim.z;
    unsigned sum, cnt, mine, sp = 0u;
    for (;;) {
        sum = 0u; cnt = 0u; mine = 0u;
#pragma unroll
        for (unsigned j = 0; j < 16; ++j) { const unsigned c = xb_ld(&bar[XB_XCNT(j)]); sum += c; cnt += (c > 0u) ? 1u : 0u; mine = (j == x) ? c : mine; }
        if (sum == G) break;
        __builtin_amdgcn_s_sleep(1);
        if ((++sp & 255u) == 0u) { if (xb_ld(&bar[XB_TMO])) break; if (sp > XB_SPIN_CAP) { atomicAdd(&bar[XB_TMO], 1u); break; } }
    }
    nloc = mine > 0u ? mine : 1u; nx = cnt > 0u ? cnt : 1u;
}
__device__ __forceinline__ void xcd_barrier(const XcdBarrier& b) {
    asm volatile("s_waitcnt vmcnt(0)" ::: "memory");
    __syncthreads();
    if (threadIdx.x == 0) {
        unsigned* bar = b.bar;
        __builtin_amdgcn_s_waitcnt(0);
        unsigned nloc = b.st[0], nx = b.st[1];
        if (nloc == 0u) { xcd_barrier_complete(bar, b.x, nloc, nx); b.st[0] = nloc; b.st[1] = nx; }
        const unsigned old = xb_add(&bar[XB_XSUB(b.x)], 1u);
        const unsigned gen = old / nloc;
        if (old + 1u == (gen + 1u) * nloc) {
            __builtin_amdgcn_fence(__ATOMIC_RELEASE, "agent");
            asm volatile("s_waitcnt vmcnt(0)" ::: "memory");
            const unsigned og = xb_add(&bar[XB_TOP], 1u);
            const unsigned tg = og / nx;
            if (og + 1u == (tg + 1u) * nx) xb_add(&bar[XB_TOPGEN], 1u);
            else XB_SPIN(xb_ld(&bar[XB_TOPGEN]) == tg, bar);
            __builtin_amdgcn_fence(__ATOMIC_ACQUIRE, "agent");
            xb_add(&bar[XB_XGEN(b.x)], 1u);
            asm volatile("s_waitcnt vmcnt(0)" ::: "memory");
        } else {
            XB_SPIN(xb_ld(&bar[XB_XGEN(b.x)]) == gen, bar);
            __builtin_amdgcn_fence(__ATOMIC_ACQUIRE, "agent");
            asm volatile("s_waitcnt vmcnt(0)" ::: "memory");
        }
    }
    __syncthreads();
}

struct Frame {
    LAS unsigned char* lds; unsigned char* ws; float* out;
    int tid, lane, wave, G, bid;
};

__device__ __forceinline__ void tr_item(const float* __restrict__ src, int ldsrc, int Ks, int Ns, int k0s, int n0s, bf16_t* dst, int ldd, LAS float* scr, int lane) {
    f32x4 tv[16];
#pragma unroll
    for (int i = 0; i < 16; ++i) { const int k = 4 * i + (lane >> 4), n4 = (lane & 15) * 4, ks = k0s + k;
        tv[i] = (f32x4){0.f, 0.f, 0.f, 0.f};
        if (ks >= 0 && ks < Ks && n0s + n4 < Ns) tv[i] = __builtin_nontemporal_load((const GAS f32x4*)((const GAS float*)src + (size_t)ks * ldsrc + n0s + n4)); }
#pragma unroll
    for (int i = 0; i < 16; ++i) { const int k = 4 * i + (lane >> 4), n4 = (lane & 15) * 4; const f32x4 v = tv[i];
        scr[(n4 + 0) * 65 + k] = v.x; scr[(n4 + 1) * 65 + k] = v.y; scr[(n4 + 2) * 65 + k] = v.z; scr[(n4 + 3) * 65 + k] = v.w; }
    asm volatile("s_waitcnt lgkmcnt(0)" ::: "memory");
    const int c = lane & 7;
#pragma unroll
    for (int j = 0; j < 8; ++j) { const int n = (lane >> 3) + 8 * j; const LAS float* s = scr + n * 65 + 8 * c;
        u32x4 o; o.x = cvt_pk_bf16(s[0], s[1]); o.y = cvt_pk_bf16(s[2], s[3]); o.z = cvt_pk_bf16(s[4], s[5]); o.w = cvt_pk_bf16(s[6], s[7]);
        *(GAS u32x4*)((GAS bf16_t*)dst + (size_t)n * ldd + 8 * c) = o; }
    asm volatile("s_waitcnt lgkmcnt(0)" ::: "memory");
}
__device__ __forceinline__ int ilv_row(int n0, int H) { return n0 < H ? 256 * (n0 / 128) + (n0 % 128) : 256 * ((n0 - H) / 128) + 128 + ((n0 - H) % 128); }

__device__ __forceinline__ void phase_prep(Frame& F, const float* const* IN) {
    const float* const* in = IN;
    LAS float* scr = (LAS float*)(F.lds + F.wave * 16640);
    const int gw = F.bid * 8 + F.wave, NGW = F.G * 8;
    constexpr int I_FI = 8 * 16 * 88, I_FO = 8 * 44 * 16, I_LI = 2 * 16 * 32, I_LG = 8 * 4 * 8, I_LO = 2 * 256, I_RKV = 6 * 256, I_WO = 2 * 256, I_L1 = 2 * 4 * 16 * 4, I_L2 = 2 * 4 * 6 * 16, I_ADA = 4 * 16 * 144;
    constexpr int NITEMS = I_FI + I_FO + I_LI + I_LG + I_LO + I_RKV + I_WO + I_L1 + I_L2 + I_ADA;
    for (int it = gw; it < NITEMS; it += NGW) {
        int r = it;
        if (r < I_FI) { const int mtx = r / 1408, q = r % 1408, kb = q / 88, nb = q % 88;
            tr_item(in[10] + (size_t)mtx * 1024 * 5632, 5632, 1024, 5632, 64 * kb, 64 * nb, (bf16_t*)(F.ws + O_WFI + mtx * SZ_WFI1) + (size_t)ilv_row(64 * nb, 2816) * 1024 + 64 * kb, 1024, scr, F.lane); continue; } r -= I_FI;
        if (r < I_FO) { const int mtx = r / 704, q = r % 704, kb = q / 16, nb = q % 16;
            tr_item(in[11] + (size_t)mtx * 2816 * 1024, 1024, 2816, 1024, 64 * kb, 64 * nb, (bf16_t*)(F.ws + O_WFO + mtx * SZ_WFO1) + (size_t)(64 * nb) * 2816 + 64 * kb, 2816, scr, F.lane); continue; } r -= I_FO;
        if (r < I_LI) { const int mtx = r / 512, q = r % 512, kb = q / 32, nb = q % 32;
            tr_item(in[12] + (size_t)mtx * 1024 * 2048, 2048, 1024, 2048, 64 * kb, 64 * nb, (bf16_t*)(F.ws + O_WLI + mtx * 2 * SZ_W1M) + (size_t)(64 * nb) * 1024 + 64 * kb, 1024, scr, F.lane); continue; } r -= I_LI;
        if (r < I_LG) { const int mtx = r / 32, q = r % 32, kb = q / 8, nb = q % 8;
            tr_item(in[15] + (size_t)mtx * 256 * 512, 512, 256, 512, 64 * kb, 64 * nb, (bf16_t*)(F.ws + O_WLG) + (size_t)mtx * 512 * 256 + (size_t)ilv_row(64 * nb, 256) * 256 + 64 * kb, 256, scr, F.lane); continue; } r -= I_LG;
        if (r < I_LO) { const int mtx = r / 256, q = r % 256, kb = q / 16, nb = q % 16;
            tr_item(in[18] + (size_t)mtx * 1024 * 1024, 1024, 1024, 1024, 64 * kb, 64 * nb, (bf16_t*)(F.ws + O_WLO + mtx * SZ_W1M) + (size_t)(64 * nb) * 1024 + 64 * kb, 1024, scr, F.lane); continue; } r -= I_LO;
        if (r < I_RKV) { const int mtx = r / 256, q = r % 256, kb = q / 16, nb = q % 16;
            tr_item(in[20] + (size_t)mtx * 1024 * 1024, 1024, 1024, 1024, 64 * kb, 64 * nb, (bf16_t*)(F.ws + O_WRKV + mtx * SZ_W1M) + (size_t)(64 * nb) * 1024 + 64 * kb, 1024, scr, F.lane); continue; } r -= I_RKV;
        if (r < I_WO) { const int mtx = r / 256, q = r % 256, kb = q / 16, nb = q % 16;
            tr_item(in[21] + (size_t)mtx * 1024 * 1024, 1024, 1024, 1024, 64 * kb, 64 * nb, (bf16_t*)(F.ws + O_WO + mtx * SZ_W1M) + (size_t)(64 * nb) * 1024 + 64 * kb, 1024, scr, F.lane); continue; } r -= I_WO;
        if (r < I_L1) { const int j = r / 256, q = r % 256, w = q / 64, q2 = q % 64, kb = q2 / 4, nb = q2 % 4;
            const float* src; int Ns;
            if (w == 0) { src = in[23] + (size_t)j * 1024 * 64; Ns = 64; } else if (w == 1) { src = in[26] + (size_t)j * 1024 * 64; Ns = 64; }
            else if (w == 2) { src = in[31] + (size_t)j * 1024 * 160; Ns = 160; } else { src = in[29]; Ns = j == 1 ? 32 : 0; }
            const int ldsrc = w == 2 ? 160 : (w == 3 ? 32 : 64);
            tr_item(src, ldsrc, 1024, Ns, 64 * kb, 64 * nb, (bf16_t*)(F.ws + O_WL1 + j * SZ_WL1) + (size_t)w * 256 * 1024 + (size_t)(64 * nb) * 1024 + 64 * kb, 1024, scr, F.lane); continue; } r -= I_L1;
        if (r < I_L2) { const int j = r / 384, q = r % 384, w = q / 96, q2 = q % 96, kb = q2 / 16, nb = q2 % 16;
            const float* src; int Ks, kd0;
            if (w == 0) { src = in[24] + (size_t)j * 64 * 1024; Ks = 64; kd0 = 0; } else if (w == 1) { src = in[27] + (size_t)j * 64 * 1024; Ks = 64; kd0 = 64; }
            else if (w == 2) { src = in[32] + (size_t)j * 160 * 1024; Ks = 160; kd0 = 128; } else { src = in[30]; Ks = j == 1 ? 32 : 0; kd0 = 288; }
            tr_item(src, 1024, Ks, 1024, 64 * kb - kd0, 64 * nb, (bf16_t*)(F.ws + O_WL2 + j * SZ_WL2) + (size_t)(w * 1024 + 64 * nb) * 384 + 64 * kb, 384, scr, F.lane); continue; } r -= I_L2;
        { const int mtx = r / 2304, q = r % 2304, kb = q / 144, nb = q % 144;
            tr_item(in[8] + (size_t)mtx * 1024 * NMODC, NMODC, 1024, NMODC, 64 * kb, 64 * nb, (bf16_t*)(F.ws + O_ADAT) + (size_t)(mtx * NMODC + 64 * nb) * 1024 + 64 * kb, 1024, scr, F.lane); }
    }
    const size_t gt = (size_t)F.bid * 512 + F.tid, NT = (size_t)F.G * 512;
    f32x4* xw = (f32x4*)(F.ws + O_XW);
    for (size_t i = (size_t)MP * 256 + gt; i < (size_t)MT * 256; i += NT) xw[i] = ((const f32x4*)in[1])[i - (size_t)MP * 256];
    { unsigned long long* xb = (unsigned long long*)(F.ws + O_XB); for (size_t i = gt; i < (size_t)128 * 2 * 8 * 32; i += NT) xb[i] = 0ull; }
    u32x2* cs = (u32x2*)(F.ws + O_CS);
    for (size_t i = gt; i < (size_t)256 * 256; i += NT) { const int row = (int)(i >> 8); f32x4 v = (f32x4){0.f, 0.f, 0.f, 0.f};
        if (row < 8) v = ((const f32x4*)in[6])[i]; else if (row < NCB) v = ((const f32x4*)in[7])[i - 8 * 256];
        u32x2 o; o.x = cvt_pk_bf16(fsilu(v.x), fsilu(v.y)); o.y = cvt_pk_bf16(fsilu(v.z), fsilu(v.w)); cs[i] = o; }
}

__device__ __forceinline__ void ld4(const GAS float* xrow, int lane, f32x4 (&v)[4]) {
    const GAS f32x4* xr = (const GAS f32x4*)xrow + lane;
#pragma unroll
    for (int j = 0; j < 4; ++j) v[j] = xr[64 * j];
}
__device__ __forceinline__ float rstd_of(const f32x4 (&v)[4], int lane) {
    float s = 0.f;
#pragma unroll
    for (int j = 0; j < 4; ++j) s += (v[j].x * v[j].x + v[j].y * v[j].y) + (v[j].z * v[j].z + v[j].w * v[j].w);
    return rsqrtf(wave_sum(s, lane) * (1.f / D) + 1e-6f);
}
__device__ __forceinline__ void fold4(GAS float* xrow, const GAS float* part, int nfold, int lane, f32x4 (&v)[4]) {
    for (int q = 0; q < nfold; ++q) { const GAS f32x4* pr = (const GAS f32x4*)(part + (size_t)q * (MS * D)) + lane;
#pragma unroll
        for (int j = 0; j < 4; ++j) v[j] += pr[64 * j]; }
    GAS f32x4* xr = (GAS f32x4*)xrow + lane;
#pragma unroll
    for (int j = 0; j < 4; ++j) xr[64 * j] = v[j];
}
__device__ __forceinline__ void norm_store(GAS bf16_t* HB, int row, int lane, const f32x4 (&v)[4], const f32x4 (&sh)[4], const f32x4 (&sc)[4]) {
    const float rstd = rstd_of(v, lane);
    GAS u32x2* o = (GAS u32x2*)(HB + (size_t)row * D) + lane;
#pragma unroll
    for (int j = 0; j < 4; ++j) { const f32x4 h = v[j] * rstd * (sc[j] + 1.f) + sh[j]; u32x2 w; w.x = cvt_pk_bf16(h.x, h.y); w.y = cvt_pk_bf16(h.z, h.w); o[64 * j] = w; }
}
__device__ __forceinline__ void phase_norm(Frame& F, const float* xprompt, int layer, int mi, int nfold) {
    GAS float* X = (GAS float*)(F.ws + O_XW); const GAS float* XP = (const GAS float*)xprompt; const GAS float* PART = (const GAS float*)(F.ws + O_PART); const GAS float* MOD = (const GAS float*)(F.ws + O_MOD); GAS bf16_t* HB = (GAS bf16_t*)(F.ws + O_HB);
    const int gw = F.bid * 8 + F.wave, NGW = F.G * 8;
    f32x4 sh[4], sc[4];
    for (int r0 = gw * 8; r0 < MP; r0 += NGW * 8) {
        const GAS float* mp = MOD + (size_t)(r0 >> 11) * (4 * NMODC) + layer * NMODC + mi * D; ld4(mp, F.lane, sh); ld4(mp + D, F.lane, sc);
        f32x4 v[3][4];
        ld4(XP + (size_t)r0 * D, F.lane, v[0]); ld4(XP + (size_t)(r0 + 1) * D, F.lane, v[1]);
#pragma unroll
        for (int i = 0; i < 8; ++i) { if (i + 2 < 8) ld4(XP + (size_t)(r0 + i + 2) * D, F.lane, v[(i + 2) % 3]); norm_store(HB, r0 + i, F.lane, v[i % 3], sh, sc); }
    }
    for (int row = MP + gw; row < MT; row += NGW) {
        const GAS float* mp = MOD + (size_t)cb_of(row) * (4 * NMODC) + layer * NMODC + mi * D; ld4(mp, F.lane, sh); ld4(mp + D, F.lane, sc);
        f32x4 v[4]; ld4(X + (size_t)row * D, F.lane, v);
        if (nfold > 0) fold4(X + (size_t)row * D, PART + (size_t)(row - MP) * D, nfold, F.lane, v);
        norm_store(HB, row, F.lane, v, sh, sc);
    }
}
__device__ __forceinline__ void norm_rwkv_emit(Frame& F, const GAS float* mu, const f32x4 (&sh)[4], const f32x4 (&sc)[4], int row, int j, const f32x4 (&v)[4], float rstd, f32x4 (&hp)[4], GAS float* shout_or_null) {
    GAS bf16_t* xm = (GAS bf16_t*)(F.ws + O_XM) + (size_t)row * D;
#pragma unroll
    for (int q = 0; q < 4; ++q) { const int c4 = F.lane + 64 * q;
        const f32x4 h = v[q] * rstd * (sc[q] + 1.f) + sh[q]; const f32x4 d = hp[q] - h;
#pragma unroll
        for (int jj = 0; jj < 6; ++jj) { const f32x4 m = *((const GAS f32x4*)(mu + jj * D) + c4); const f32x4 x = h + d * m;
            u32x2 w; w.x = cvt_pk_bf16(x.x, x.y); w.y = cvt_pk_bf16(x.z, x.w); *((GAS u32x2*)(xm + (size_t)jj * MT * D) + c4) = w; }
        if (shout_or_null) *((GAS f32x4*)shout_or_null + c4) = h;
        hp[q] = h; }
    GAS bf16_t* ac = (GAS bf16_t*)(F.ws + O_ACAT) + (size_t)row * 384;
    if (F.lane < 32) ((GAS unsigned*)(ac + 320))[F.lane] = 0u; else if (j == 0 && F.lane < 48) ((GAS unsigned*)(ac + 288))[F.lane - 32] = 0u;
}
__device__ __forceinline__ void phase_norm_rwkv(Frame& F, const float* const* IN, int layer, int j, int nfold) {
    GAS float* X = (GAS float*)(F.ws + O_XW); const GAS float* MOD = (const GAS float*)(F.ws + O_MOD); const GAS float* PART = (const GAS float*)(F.ws + O_PART);
    const GAS float* mu = (const GAS float*)IN[19] + (size_t)j * 6 * D;
    const int gw = F.bid * 8 + F.wave, NGW = F.G * 8;
    f32x4 v[4], hp[4], sh[4], sc[4];
    for (int r0 = gw * 8; r0 < MP; r0 += NGW * 8) {
        const int b = r0 >> 11, t0 = r0 & 2047;
        const GAS float* mp = MOD + (size_t)b * (4 * NMODC) + layer * NMODC + 3 * D; ld4(mp, F.lane, sh); ld4(mp + D, F.lane, sc);
        f32x4 w[3][4];
        ld4(X + (size_t)r0 * D, F.lane, w[0]); ld4(X + (size_t)(r0 + 1) * D, F.lane, w[1]);
        if (t0 == 0) {
#pragma unroll
            for (int q = 0; q < 4; ++q) hp[q] = (f32x4){0.f, 0.f, 0.f, 0.f}; }
        else { f32x4 p[4]; ld4(X + (size_t)(r0 - 1) * D, F.lane, p); const float rp = rstd_of(p, F.lane);
#pragma unroll
            for (int q = 0; q < 4; ++q) hp[q] = p[q] * rp * (sc[q] + 1.f) + sh[q]; }
#pragma unroll
        for (int i = 0; i < 8; ++i) { if (i + 2 < 8) ld4(X + (size_t)(r0 + i + 2) * D, F.lane, w[(i + 2) % 3]);
            const float rstd = rstd_of(w[i % 3], F.lane);
            norm_rwkv_emit(F, mu, sh, sc, r0 + i, j, w[i % 3], rstd, hp, (i == 7 && t0 == 2040) ? (GAS float*)F.out + OUT_P_SHIFT + (size_t)(j * 8 + b) * D : nullptr); }
    }
    for (int b = gw; b < 128; b += NGW) {
        ld4((const GAS float*)IN[4] + (size_t)(j * 128 + b) * D, F.lane, hp);
        const GAS float* mp = MOD + (size_t)(8 + b) * (4 * NMODC) + layer * NMODC + 3 * D; ld4(mp, F.lane, sh); ld4(mp + D, F.lane, sc);
        for (int t = 0; t < 8; ++t) { const int row = MP + b * 8 + t;
            ld4(X + (size_t)row * D, F.lane, v);
            if (nfold > 0) fold4(X + (size_t)row * D, PART + (size_t)(row - MP) * D, nfold, F.lane, v);
            const float rstd = rstd_of(v, F.lane);
            norm_rwkv_emit(F, mu, sh, sc, row, j, v, rstd, hp, t == 7 ? (GAS float*)F.out + OUT_S_SHIFT + (size_t)(j * 128 + b) * D : nullptr); }
    }
}
__device__ __forceinline__ void final_store(GAS float* OUT, int row, int lane, const f32x4 (&v)[4], const f32x4 (&gn)[4]) {
    const float rstd = rstd_of(v, lane);
    GAS f32x4* o = (GAS f32x4*)(OUT + OUT_Y + (size_t)row * D) + lane;
#pragma unroll
    for (int j = 0; j < 4; ++j) __builtin_nontemporal_store(v[j] * rstd * gn[j], o + 64 * j);
}
__device__ __forceinline__ void phase_final(Frame& F, const float* const* IN, int nfold) {
    GAS float* X = (GAS float*)(F.ws + O_XW); const GAS float* PART = (const GAS float*)(F.ws + O_PART); GAS float* OUT = (GAS float*)F.out;
    const int gw = F.bid * 8 + F.wave, NGW = F.G * 8;
    f32x4 gn[4]; ld4((const GAS float*)IN[38], F.lane, gn);
    for (int r0 = gw * 8; r0 < MP; r0 += NGW * 8) {
        f32x4 v[3][4];
        ld4(X + (size_t)r0 * D, F.lane, v[0]); ld4(X + (size_t)(r0 + 1) * D, F.lane, v[1]);
#pragma unroll
        for (int i = 0; i < 8; ++i) { if (i + 2 < 8) ld4(X + (size_t)(r0 + i + 2) * D, F.lane, v[(i + 2) % 3]); final_store(OUT, r0 + i, F.lane, v[i % 3], gn); }
    }
    for (int row = MP + gw; row < MT; row += NGW) {
        f32x4 v[4]; ld4(X + (size_t)row * D, F.lane, v);
        if (nfold > 0) fold4(X + (size_t)row * D, PART + (size_t)(row - MP) * D, nfold, F.lane, v);
        final_store(OUT, row, F.lane, v, gn);
    }
}

__device__ __forceinline__ void phase_conv(Frame& F, const float* const* IN, int j) {
    const GAS float* REC = (const GAS float*)(F.ws + O_REC); GAS bf16_t* XC = (GAS bf16_t*)(F.ws + O_XC);
    const GAS float* cw = (const GAS float*)IN[13] + (size_t)j * 4 * D; const GAS float* cbias = (const GAS float*)IN[14] + (size_t)j * D;
    const int gt = F.bid * 512 + F.tid, NT = F.G * 512;
    for (int i = gt; i < (MT / 34) * 256; i += NT) {
        const int c4 = i & 255, ra = (i >> 8) * 34;
        const f32x4 k0 = *((const GAS f32x4*)cw + c4), k1 = *((const GAS f32x4*)(cw + D) + c4), k2 = *((const GAS f32x4*)(cw + 2 * D) + c4), k3 = *((const GAS f32x4*)(cw + 3 * D) + c4), kb = *((const GAS f32x4*)cbias + c4);
        f32x4 w0, w1, w2;
        { const int row = ra; int t; const GAS float* buf = nullptr;
          if (row < MP) t = row & 2047; else { t = (row - MP) & 7; buf = (const GAS float*)IN[3] + (size_t)(j * 128 + ((row - MP) >> 3)) * 3 * D; }
          const f32x4 z = (f32x4){0.f, 0.f, 0.f, 0.f};
          w0 = t >= 3 ? *((const GAS f32x4*)(REC + (size_t)(row - 3) * D) + c4) : (buf ? *((const GAS f32x4*)(buf + (size_t)t * D) + c4) : z);
          w1 = t >= 2 ? *((const GAS f32x4*)(REC + (size_t)(row - 2) * D) + c4) : (buf ? *((const GAS f32x4*)(buf + (size_t)(t + 1) * D) + c4) : z);
          w2 = t >= 1 ? *((const GAS f32x4*)(REC + (size_t)(row - 1) * D) + c4) : (buf ? *((const GAS f32x4*)(buf + (size_t)(t + 2) * D) + c4) : z); }
        for (int bb = 0; bb < 2; ++bb) {
            f32x4 cv[17];
#pragma unroll
            for (int r = 0; r < 17; ++r) cv[r] = *((const GAS f32x4*)(REC + (size_t)(ra + bb * 17 + r) * D) + c4);
#pragma unroll
            for (int r = 0; r < 17; ++r) {
                const int row = ra + bb * 17 + r; int b, t, T; GAS float* cout;
                if (row < MP) { b = row >> 11; t = row & 2047; T = 2048; cout = (GAS float*)F.out + OUT_P_CONV + (size_t)(j * 8 + b) * 3 * D;
                    if (t == 0) { w0 = w1 = w2 = (f32x4){0.f, 0.f, 0.f, 0.f}; } }
                else { b = (row - MP) >> 3; t = (row - MP) & 7; T = 8; cout = (GAS float*)F.out + OUT_S_CONV + (size_t)(j * 128 + b) * 3 * D;
                    if (t == 0) { const GAS float* buf = (const GAS float*)IN[3] + (size_t)(j * 128 + b) * 3 * D; w0 = *((const GAS f32x4*)buf + c4); w1 = *((const GAS f32x4*)(buf + D) + c4); w2 = *((const GAS f32x4*)(buf + 2 * D) + c4); } }
                const f32x4 cur = cv[r];
                const f32x4 y = kb + w0 * k0 + w1 * k1 + w2 * k2 + cur * k3;
                u32x2 w; w.x = cvt_pk_bf16(y.x, y.y); w.y = cvt_pk_bf16(y.z, y.w); *((GAS u32x2*)(XC + (size_t)row * D) + c4) = w;
                if (t >= T - 3) *((GAS f32x4*)(cout + (size_t)(t - (T - 3)) * D) + c4) = cur;
                w0 = w1; w1 = w2; w2 = cur;
            }
        }
    }
}
__device__ __forceinline__ void phase_scan_a(Frame& F) {
    const GAS float* AA = (const GAS float*)(F.ws + O_AA); const GAS float* UU = (const GAS float*)(F.ws + O_UU); GAS f32x2* AGG = (GAS f32x2*)(F.ws + O_AGG);
    const int gt = F.bid * 512 + F.tid, NT = F.G * 512;
    for (int i = gt; i < 8 * 16 * 1024; i += NT) { const int ch = i & 1023, seg = (i >> 10) & 15, b = i >> 14;
        const size_t base = ((size_t)b * 2048 + seg * 128) * D + ch; float P = 1.f, h = 0.f;
#pragma unroll 16
        for (int t = 0; t < 128; ++t) { const float a = AA[base + (size_t)t * D], u = UU[base + (size_t)t * D]; P *= a; h = a * h + u; }
        AGG[i] = (f32x2){P, h}; }
}
__device__ __forceinline__ void phase_scan_b(Frame& F, const float* const* IN, int j) {
    const GAS float* AA = (const GAS float*)(F.ws + O_AA); const GAS float* UU = (const GAS float*)(F.ws + O_UU); const GAS f32x2* AGG = (const GAS f32x2*)(F.ws + O_AGG);
    const GAS bf16_t* GG = (const GAS bf16_t*)(F.ws + O_GG); GAS bf16_t* HB = (GAS bf16_t*)(F.ws + O_HB); GAS float* OUT = (GAS float*)F.out;
    const int gt = F.bid * 512 + F.tid, NT = F.G * 512;
    for (int i = gt; i < 2 * 8 * 16 * 1024; i += NT) {
        if (i < 8 * 16 * 1024) { const int ch = i & 1023, seg = (i >> 10) & 15, b = i >> 14;
            float h = 0.f;
#pragma unroll
            for (int q = 0; q < 15; ++q) { const f32x2 g = AGG[(b * 16 + (q < seg ? q : 0)) * 1024 + ch]; h = q < seg ? g.x * h + g.y : h; }
            const size_t base = ((size_t)b * 2048 + seg * 128) * D + ch;
#pragma unroll 16
            for (int t = 0; t < 128; ++t) { const size_t o = base + (size_t)t * D; h = AA[o] * h + UU[o]; HB[o] = (bf16_t)(cvt_pk_bf16(h * bf_lo((unsigned)GG[o]), 0.f) & 0xffffu); }
            if (seg == 15) OUT[OUT_P_H + (size_t)(j * 8 + b) * D + ch] = h;
        } else { const int q = i - 8 * 16 * 1024, ch = q & 1023, b = q >> 10;
            float h = ((const GAS float*)IN[2])[(size_t)(j * 128 + b) * D + ch];
            const size_t base = ((size_t)MP + b * 8) * D + ch;
#pragma unroll
            for (int t = 0; t < 8; ++t) { const size_t o = base + (size_t)t * D; h = AA[o] * h + UU[o]; HB[o] = (bf16_t)(cvt_pk_bf16(h * bf_lo((unsigned)GG[o]), 0.f) & 0xffffu); }
            OUT[OUT_S_H + (size_t)(j * 128 + b) * D + ch] = h; }
    }
}

__device__ __forceinline__ void wkv_full(Frame& F, const float* const* IN, int j, int it, int step, int itend) {
    const GAS bf16_t* Rb = (const GAS bf16_t*)(F.ws + O_R); const GAS bf16_t* Kb = (const GAS bf16_t*)(F.ws + O_K);
    const GAS float* Vb = (const GAS float*)(F.ws + O_V); const GAS float* Wb = (const GAS float*)(F.ws + O_WD); const GAS float* Ab = (const GAS float*)(F.ws + O_AS); const GAS float* Gb = (const GAS float*)(F.ws + O_GS);
    GAS bf16_t* HB = (GAS bf16_t*)(F.ws + O_HB);
    const GAS float* k_k = (const GAS float*)IN[33] + (size_t)j * D; const GAS float* k_a = (const GAS float*)IN[34] + (size_t)j * D; const GAS float* r_k = (const GAS float*)IN[35] + (size_t)j * D;
    const GAS float* ln_w = (const GAS float*)IN[36] + (size_t)j * D; const GAS float* ln_b = (const GAS float*)IN[37] + (size_t)j * D;
    LAS float* sr = (LAS float*)F.lds; LAS float* sw = sr + 1024; LAS float* sk = sw + 1024; LAS float* sa = sk + 1024; LAS float* sb = sa + 1024; LAS float* sv = sb + 1024; LAS float* sy = sv + 1024;
    const int tt = F.tid >> 5, kp = F.tid & 31;
    const int srow = (F.wave & 3) * 16 + 2 * (F.lane >> 3), seg = F.lane & 7;
    for (; it < itend; it += step) {
        int b, h, T, row0; const GAS float* S0 = nullptr; GAS float* Sout;
        if (it < 128) { b = it >> 4; h = it & 15; T = 2048; row0 = b * 2048; Sout = (GAS float*)F.out + OUT_P_WKV + ((size_t)(j * 8 + b) * 16 + h) * 4096; }
        else { const int si = it - 128; b = si >> 4; h = si & 15; T = 8; row0 = MP + b * 8; S0 = (const GAS float*)IN[5] + ((size_t)(j * 128 + b) * 16 + h) * 4096; Sout = (GAS float*)F.out + OUT_S_WKV + ((size_t)(j * 128 + b) * 16 + h) * 4096; }
        const int ct = T < 16 ? T : 16, nch = T / ct;
        f32x2 Sa[4], Sb[4];
        if (S0) { const f32x4 s0 = __builtin_nontemporal_load((const GAS f32x4*)(S0 + srow * 64 + seg * 8)), s1 = __builtin_nontemporal_load((const GAS f32x4*)(S0 + srow * 64 + seg * 8 + 4)), s2 = __builtin_nontemporal_load((const GAS f32x4*)(S0 + srow * 64 + 64 + seg * 8)), s3 = __builtin_nontemporal_load((const GAS f32x4*)(S0 + srow * 64 + 64 + seg * 8 + 4));
            Sa[0] = s0.xy; Sa[1] = s0.zw; Sa[2] = s1.xy; Sa[3] = s1.zw; Sb[0] = s2.xy; Sb[1] = s2.zw; Sb[2] = s3.xy; Sb[3] = s3.zw; }
        else {
#pragma unroll
            for (int i = 0; i < 4; ++i) { Sa[i] = (f32x2){0.f, 0.f}; Sb[i] = (f32x2){0.f, 0.f}; } }
        const int col = h * 64 + 2 * kp;
        const f32x2 ckk = *(const GAS f32x2*)(k_k + col), cka = *(const GAS f32x2*)(k_a + col), crk = *(const GAS f32x2*)(r_k + col), clw = *(const GAS f32x2*)(ln_w + col), clb = *(const GAS f32x2*)(ln_b + col);
        const bool act = tt < ct;
        unsigned nr = 0, nk = 0; f32x2 nv = {0.f, 0.f}, nw = {0.f, 0.f}, na = {0.f, 0.f}, ng = {0.f, 0.f};
        if (act) { const size_t o = (size_t)(row0 + tt) * D + col; nr = *(const GAS unsigned*)(Rb + o); nk = *(const GAS unsigned*)(Kb + o); nv = *(const GAS f32x2*)(Vb + o); nw = *(const GAS f32x2*)(Wb + o); na = *(const GAS f32x2*)(Ab + o); ng = *(const GAS f32x2*)(Gb + o); }
        for (int c = 0; c < nch; ++c) {
            const f32x2 r2 = {bf_lo(nr), bf_hi(nr)}, k2 = {bf_lo(nk), bf_hi(nk)}, v2 = nv, w2 = nw, a2 = na, g2 = ng;
            float rk = 0.f;
            if (act) {
                f32x2 kk = k2 * ckk; const float ss = half_sum(kk.x * kk.x + kk.y * kk.y, F.lane);
                kk = kk * frcp(fmaxf(sqrtf(ss), 1e-12f));
                const f32x2 kn = k2 * ((a2 - 1.f) * cka + 1.f);
                rk = half_sum(r2.x * kn.x * crk.x + r2.y * kn.y * crk.y, F.lane);
                const int o = tt * 64 + 2 * kp;
                *(LAS f32x2*)(sr + o) = r2; *(LAS f32x2*)(sw + o) = w2; *(LAS f32x2*)(sk + o) = kn; *(LAS f32x2*)(sa + o) = -kk; *(LAS f32x2*)(sb + o) = kk * a2; *(LAS f32x2*)(sv + o) = v2;
            }
            if (act && c + 1 < nch) { const size_t o = (size_t)(row0 + (c + 1) * ct + tt) * D + col; nr = *(const GAS unsigned*)(Rb + o); nk = *(const GAS unsigned*)(Kb + o); nv = *(const GAS f32x2*)(Vb + o); nw = *(const GAS f32x2*)(Wb + o); na = *(const GAS f32x2*)(Ab + o); ng = *(const GAS f32x2*)(Gb + o); }
            { asm volatile("s_waitcnt lgkmcnt(0)" ::: "memory"); __builtin_amdgcn_s_barrier(); asm volatile("" ::: "memory"); }
            if (F.wave < 4) {
                f32x4 Pa0, Pa1, Pw0, Pw1, Pb0, Pb1, Pk0, Pk1, Pr0, Pr1; f32x2 Pvv;
                f32x4 Qa0, Qa1, Qw0, Qw1, Qb0, Qb1, Qk0, Qk1, Qr0, Qr1; f32x2 Qvv;
#define WKV_LD(P, t_) do { const int _o = (t_) * 64 + seg * 8; P##a0 = *(const LAS f32x4*)(sa + _o); P##a1 = *(const LAS f32x4*)(sa + _o + 4); P##w0 = *(const LAS f32x4*)(sw + _o); P##w1 = *(const LAS f32x4*)(sw + _o + 4); \
                    P##b0 = *(const LAS f32x4*)(sb + _o); P##b1 = *(const LAS f32x4*)(sb + _o + 4); P##k0 = *(const LAS f32x4*)(sk + _o); P##k1 = *(const LAS f32x4*)(sk + _o + 4); \
                    P##r0 = *(const LAS f32x4*)(sr + _o); P##r1 = *(const LAS f32x4*)(sr + _o + 4); P##vv = *(const LAS f32x2*)(sv + (t_) * 64 + srow); } while (0)
#define WKV_ROW(S, P, vsc, yout) do { f32x2 q = S[0] * P##a0.xy; q = S[1] * P##a0.zw + q; f32x2 q2 = S[2] * P##a1.xy; q2 = S[3] * P##a1.zw + q2; q += q2; \
                    const float p = sum8(q.x + q.y); const f32x2 pp = {p, p}, v2s = {vsc, vsc}; \
                    S[0] = S[0] * P##w0.xy + pp * P##b0.xy + v2s * P##k0.xy; S[1] = S[1] * P##w0.zw + pp * P##b0.zw + v2s * P##k0.zw; \
                    S[2] = S[2] * P##w1.xy + pp * P##b1.xy + v2s * P##k1.xy; S[3] = S[3] * P##w1.zw + pp * P##b1.zw + v2s * P##k1.zw; \
                    f32x2 y2 = S[0] * P##r0.xy; y2 = S[1] * P##r0.zw + y2; f32x2 y3 = S[2] * P##r1.xy; y3 = S[3] * P##r1.zw + y3; y2 += y3; \
                    yout = sum8(y2.x + y2.y); } while (0)
#define WKV_STEP(P, t_) do { float ya, yb; WKV_ROW(Sa, P, P##vv.x, ya); WKV_ROW(Sb, P, P##vv.y, yb); *(LAS f32x2*)(sy + (t_) * 64 + srow) = (f32x2){ya, yb}; } while (0)
                WKV_LD(P, 0);
                for (int t = 0; t < ct; t += 2) {
                    WKV_LD(Q, t + 1);
                    WKV_STEP(P, t);
                    if (t + 2 < ct) WKV_LD(P, t + 2);
                    WKV_STEP(Q, t + 1);
                }
#undef WKV_LD
#undef WKV_ROW
#undef WKV_STEP
            }
            { asm volatile("s_waitcnt lgkmcnt(0)" ::: "memory"); __builtin_amdgcn_s_barrier(); asm volatile("" ::: "memory"); }
            if (act) {
                const f32x2 y2 = *(const LAS f32x2*)(sy + tt * 64 + 2 * kp);
                const float mean = half_sum(y2.x + y2.y, F.lane) * (1.f / 64.f);
                const f32x2 d = y2 - mean; const float var = half_sum(d.x * d.x + d.y * d.y, F.lane) * (1.f / 64.f);
                const float rs = rsqrtf(var + 64e-5f);
                const f32x2 o2 = (d * rs * clw + clb + v2 * rk) * g2;
                *(GAS unsigned*)(HB + (size_t)(row0 + c * ct + tt) * D + col) = cvt_pk_bf16(o2.x, o2.y);
            }
        }
        if (F.wave < 4) { __builtin_nontemporal_store((f32x4){Sa[0].x, Sa[0].y, Sa[1].x, Sa[1].y}, (GAS f32x4*)(Sout + srow * 64 + seg * 8)); __builtin_nontemporal_store((f32x4){Sa[2].x, Sa[2].y, Sa[3].x, Sa[3].y}, (GAS f32x4*)(Sout + srow * 64 + seg * 8 + 4));
            __builtin_nontemporal_store((f32x4){Sb[0].x, Sb[0].y, Sb[1].x, Sb[1].y}, (GAS f32x4*)(Sout + srow * 64 + 64 + seg * 8)); __builtin_nontemporal_store((f32x4){Sb[2].x, Sb[2].y, Sb[3].x, Sb[3].y}, (GAS f32x4*)(Sout + srow * 64 + 64 + seg * 8 + 4)); }
        { asm volatile("s_waitcnt lgkmcnt(0)" ::: "memory"); __builtin_amdgcn_s_barrier(); asm volatile("" ::: "memory"); }
    }
}


__device__ __forceinline__ void wkv_half(Frame& F, const float* const* IN, int j) {
    const GAS bf16_t* Rb = (const GAS bf16_t*)(F.ws + O_R); const GAS bf16_t* Kb = (const GAS bf16_t*)(F.ws + O_K);
    const GAS float* Vb = (const GAS float*)(F.ws + O_V); const GAS float* Wb = (const GAS float*)(F.ws + O_WD); const GAS float* Ab = (const GAS float*)(F.ws + O_AS); const GAS float* Gb = (const GAS float*)(F.ws + O_GS);
    GAS bf16_t* HB = (GAS bf16_t*)(F.ws + O_HB);
    const GAS float* k_k = (const GAS float*)IN[33] + (size_t)j * D; const GAS float* k_a = (const GAS float*)IN[34] + (size_t)j * D; const GAS float* r_k = (const GAS float*)IN[35] + (size_t)j * D;
    const GAS float* ln_w = (const GAS float*)IN[36] + (size_t)j * D; const GAS float* ln_b = (const GAS float*)IN[37] + (size_t)j * D;
    LAS float* sr = (LAS float*)F.lds;
    LAS float* sw = sr + 2048; LAS float* sk = sw + 2048; LAS float* sa = sk + 2048; LAS float* sb = sa + 2048;
    LAS float* sv = sb + 2048;
    LAS float* sg = sv + 8 * 1024;
    LAS float* sy = sg + 8 * 1024;
    LAS float* srk = sy + 8 * 512;
    LAS float* sst = srk + 8 * 16;
    const int item = ((F.bid >> 4) << 3) | (F.bid & 7), half = (F.bid >> 3) & 1, b = item >> 4, h = item & 15, row0 = b * 2048, rbase = 32 * half;
    GAS unsigned long long* xmine = (GAS unsigned long long*)(F.ws + O_XB) + (size_t)((item * 2 + half) * 8) * 32;
    GAS unsigned long long* xpart = (GAS unsigned long long*)(F.ws + O_XB) + (size_t)((item * 2 + (half ^ 1)) * 8) * 32;
    const unsigned tagbase = (unsigned)(j + 1) << 16;
#define WKV_BAR() do { asm volatile("s_waitcnt lgkmcnt(0)" ::: "memory"); __builtin_amdgcn_s_barrier(); asm volatile("" ::: "memory"); } while (0)
    if (F.wave < 4) {
        const int srow = rbase + F.wave * 8 + (F.lane >> 3), seg = F.lane & 7;
        f32x2 S[4];
#pragma unroll
        for (int i = 0; i < 4; ++i) S[i] = (f32x2){0.f, 0.f};
        WKV_BAR();
        __builtin_amdgcn_s_setprio(3);
        for (int c = 0; c < 131; ++c) {
            if (c < 128) {
                const int bi = c & 7, vo = (c & 1) * 1024;
                f32x4 Pa0, Pa1, Pw0, Pw1, Pb0, Pb1, Pk0, Pk1, Pr0, Pr1; float Pvv;
                f32x4 Qa0, Qa1, Qw0, Qw1, Qb0, Qb1, Qk0, Qk1, Qr0, Qr1; float Qvv;
#define WKV_LD(P, t_) do { const int _o = vo + (t_) * 64 + seg * 8; P##a0 = *(const LAS f32x4*)(sa + _o); P##a1 = *(const LAS f32x4*)(sa + _o + 4); P##w0 = *(const LAS f32x4*)(sw + _o); P##w1 = *(const LAS f32x4*)(sw + _o + 4); \
                P##b0 = *(const LAS f32x4*)(sb + _o); P##b1 = *(const LAS f32x4*)(sb + _o + 4); P##k0 = *(const LAS f32x4*)(sk + _o); P##k1 = *(const LAS f32x4*)(sk + _o + 4); \
                P##r0 = *(const LAS f32x4*)(sr + _o); P##r1 = *(const LAS f32x4*)(sr + _o + 4); P##vv = sv[bi * 1024 + (t_) * 64 + srow]; } while (0)
#define WKV_STEP(P, N, t_, HASN) do { const f32x2 pp = {pa, pa}, v2s = {P##vv, P##vv}; \
                S[0] = S[0] * P##w0.xy + pp * P##b0.xy + v2s * P##k0.xy; S[1] = S[1] * P##w0.zw + pp * P##b0.zw + v2s * P##k0.zw; \
                S[2] = S[2] * P##w1.xy + pp * P##b1.xy + v2s * P##k1.xy; S[3] = S[3] * P##w1.zw + pp * P##b1.zw + v2s * P##k1.zw; \
                f32x2 y2 = S[0] * P##r0.xy; y2 = S[1] * P##r0.zw + y2; f32x2 y3 = S[2] * P##r1.xy; y3 = S[3] * P##r1.zw + y3; y2 += y3; \
                float ys = y2.x + y2.y; \
                if (HASN) { f32x2 q = S[0] * N##a0.xy; q = S[1] * N##a0.zw + q; f32x2 q2 = S[2] * N##a1.xy; q2 = S[3] * N##a1.zw + q2; q += q2; float qs = q.x + q.y; \
                    ys += dpp_f<0xB1>(ys); qs += dpp_f<0xB1>(qs); ys += dpp_f<0x4E>(ys); qs += dpp_f<0x4E>(qs); ys += dpp_f<0x141>(ys); qs += dpp_f<0x141>(qs); pa = qs; } \
                else ys = sum8(ys); \
                sy[bi * 512 + (t_) * 32 + (srow - rbase)] = ys; } while (0)
                WKV_LD(P, 0);
                float pa; { f32x2 q = S[0] * Pa0.xy; q = S[1] * Pa0.zw + q; f32x2 q2 = S[2] * Pa1.xy; q2 = S[3] * Pa1.zw + q2; q += q2; pa = sum8(q.x + q.y); }
                for (int t = 0; t < 16; t += 2) {
                    WKV_LD(Q, t + 1);
                    WKV_STEP(P, Q, t, true);
                    if (t + 2 < 16) WKV_LD(P, t + 2);
                    WKV_STEP(Q, P, t + 1, t + 2 < 16);
                }
#undef WKV_LD
#undef WKV_STEP
            }
            WKV_BAR();
        }
        __builtin_amdgcn_s_setprio(0);
        GAS float* Sout = (GAS float*)F.out + OUT_P_WKV + ((size_t)(j * 8 + b) * 16 + h) * 4096 + (size_t)srow * 64 + seg * 8;
        *(GAS f32x4*)Sout = (f32x4){S[0].x, S[0].y, S[1].x, S[1].y}; *(GAS f32x4*)(Sout + 4) = (f32x4){S[2].x, S[2].y, S[3].x, S[3].y};
    } else {
        const int lid = F.tid - 256, tt = lid >> 4, kq = lid & 15;
        const int col = h * 64 + 4 * kq, pc = h * 64 + rbase + 2 * kq;
        const f32x4 ckk = *(const GAS f32x4*)(k_k + col), cka = *(const GAS f32x4*)(k_a + col), crk = *(const GAS f32x4*)(r_k + col);
        const f32x2 plw = *(const GAS f32x2*)(ln_w + pc), plb = *(const GAS f32x2*)(ln_b + pc);
        u32x2 nr, nk; f32x4 nv, nw, na, ng;
#define WKV_GLD(cc) do { const size_t _o = (size_t)(row0 + (cc) * 16 + tt) * D + col; nr = __builtin_nontemporal_load((const GAS u32x2*)(Rb + _o)); nk = __builtin_nontemporal_load((const GAS u32x2*)(Kb + _o)); nv = __builtin_nontemporal_load((const GAS f32x4*)(Vb + _o)); nw = __builtin_nontemporal_load((const GAS f32x4*)(Wb + _o)); na = __builtin_nontemporal_load((const GAS f32x4*)(Ab + _o)); ng = __builtin_nontemporal_load((const GAS f32x4*)(Gb + _o)); } while (0)
#define WKV_PREP(cc) do { const int _bi = (cc) & 7, _vo = ((cc) & 1) * 1024; \
            const f32x4 r4 = {bf_lo(nr.x), bf_hi(nr.x), bf_lo(nr.y), bf_hi(nr.y)}, k4 = {bf_lo(nk.x), bf_hi(nk.x), bf_lo(nk.y), bf_hi(nk.y)}; \
            f32x4 kk = k4 * ckk; const float ss = row16_sum((kk.x * kk.x + kk.y * kk.y) + (kk.z * kk.z + kk.w * kk.w)); \
            kk = kk * frcp(fmaxf(sqrtf(ss), 1e-12f)); \
            const f32x4 kn = k4 * ((na - 1.f) * cka + 1.f); \
            const float rk = row16_sum((r4.x * kn.x * crk.x + r4.y * kn.y * crk.y) + (r4.z * kn.z * crk.z + r4.w * kn.w * crk.w)); \
            const int _o = tt * 64 + 4 * kq; \
            *(LAS f32x4*)(sr + _vo + _o) = r4; *(LAS f32x4*)(sw + _vo + _o) = nw; *(LAS f32x4*)(sk + _vo + _o) = kn; *(LAS f32x4*)(sa + _vo + _o) = -kk; *(LAS f32x4*)(sb + _vo + _o) = kk * na; \
            *(LAS f32x4*)(sv + _bi * 1024 + _o) = nv; *(LAS f32x4*)(sg + _bi * 1024 + _o) = ng; if (kq == 0) srk[_bi * 16 + tt] = rk; } while (0)
#define WKV_XLD(cc, g1_, g2_) do { g1_ = __hip_atomic_load(xpart + ((cc) & 7) * 32 + tt * 2, __ATOMIC_RELAXED, __HIP_MEMORY_SCOPE_AGENT); g2_ = __hip_atomic_load(xpart + ((cc) & 7) * 32 + tt * 2 + 1, __ATOMIC_RELAXED, __HIP_MEMORY_SCOPE_AGENT); } while (0)
        WKV_GLD(0); WKV_PREP(0); WKV_GLD(1);
        WKV_BAR();
        for (int c = 0; c < 131; ++c) {
            unsigned long long eg1 = 0ull, eg2 = 0ull;
            if (c >= 3) WKV_XLD(c - 3, eg1, eg2);
            if (c >= 1 && c <= 128) {
                const int cc = c - 1, bi = cc & 7;
                const f32x2 y = *(const LAS f32x2*)(sy + bi * 512 + tt * 32 + 2 * kq);
                const float s1 = row16_sum(y.x + y.y), s2 = row16_sum(y.x * y.x + y.y * y.y);
                if (kq == 0) { sst[bi * 32 + tt * 2] = s1; sst[bi * 32 + tt * 2 + 1] = s2;
                    const unsigned long long tg = (unsigned long long)(tagbase | (unsigned)(cc + 1)) << 32;
                    __hip_atomic_store(xmine + (cc & 7) * 32 + tt * 2, tg | (unsigned long long)__float_as_uint(s1), __ATOMIC_RELAXED, __HIP_MEMORY_SCOPE_AGENT);
                    __hip_atomic_store(xmine + (cc & 7) * 32 + tt * 2 + 1, tg | (unsigned long long)__float_as_uint(s2), __ATOMIC_RELAXED, __HIP_MEMORY_SCOPE_AGENT); }
            }
            if (c + 1 < 128) { WKV_PREP(c + 1); if (c + 2 < 128) WKV_GLD(c + 2); }
            if (c >= 3) {
                const int cc = c - 3, bi = cc & 7;
                const f32x2 y = *(const LAS f32x2*)(sy + bi * 512 + tt * 32 + 2 * kq); const float s1 = sst[bi * 32 + tt * 2], s2 = sst[bi * 32 + tt * 2 + 1];
                const unsigned tag = tagbase | (unsigned)(cc + 1);
                for (int sp = 0; sp < (1 << 20); ++sp) { if ((unsigned)(eg1 >> 32) == tag && (unsigned)(eg2 >> 32) == tag) break; __builtin_amdgcn_s_sleep(1); WKV_XLD(cc, eg1, eg2); }
                const float mean = (s1 + __uint_as_float((unsigned)eg1)) * (1.f / 64.f); const float var = fmaxf((s2 + __uint_as_float((unsigned)eg2)) * (1.f / 64.f) - mean * mean, 0.f);
                const float rs = rsqrtf(var + 64e-5f);
                const f32x2 v2 = *(const LAS f32x2*)(sv + bi * 1024 + tt * 64 + rbase + 2 * kq), g2 = *(const LAS f32x2*)(sg + bi * 1024 + tt * 64 + rbase + 2 * kq); const float rk = srk[bi * 16 + tt];
                const f32x2 o2 = ((y - mean) * rs * plw + plb + v2 * rk) * g2;
                *(GAS unsigned*)(HB + (size_t)(row0 + cc * 16 + tt) * D + pc) = cvt_pk_bf16(o2.x, o2.y);
            }
            WKV_BAR();
        }
#undef WKV_GLD
#undef WKV_PREP
#undef WKV_XLD
    }
    WKV_BAR();
#undef WKV_BAR
}
__device__ __forceinline__ void phase_wkv(Frame& F, const float* const* IN, int j) {
    if (F.G == 256) { wkv_half(F, IN, j); wkv_full(F, IN, j, 128 + F.bid, 256, 128 + 2048); }
    else wkv_full(F, IN, j, F.bid, F.G, 128 + 2048);
}

constexpr int NPH = 2 + 13 + 11 + 13 + 11 + 1;
__global__ void __launch_bounds__(512, 2) mk_fwd(Args args) {
    extern __shared__ __attribute__((aligned(16))) unsigned char shm[];
    cg::grid_group grid = cg::this_grid();
    Frame F; F.lds = (LAS unsigned char*)shm; F.ws = args.ws; F.out = args.out;
    const int wave0 = __builtin_amdgcn_readfirstlane(threadIdx.x >> 6);
    F.tid = threadIdx.x; F.lane = threadIdx.x & 63; F.wave = wave0; F.G = gridDim.x; F.bid = blockIdx.x;
    const int lo = args.lo, hi = args.hi;
    if (threadIdx.x == 0) { const float** tab = (const float**)(args.ws + O_TAB);
#pragma unroll
        for (int i = 0; i < 39; ++i) tab[i] = args.in[i]; }
    if (threadIdx.x < 2) ((volatile LAS unsigned*)(F.lds + LDS_BYTES - 64))[threadIdx.x] = 0u;
    __threadfence(); __syncthreads();
    XcdBarrier bar = xcd_barrier_post((unsigned*)(args.ws + O_BAR), (volatile LAS unsigned*)(F.lds + LDS_BYTES - 64));
    int ph = 0;
#define RUNG(grp, ...) do { if (ph >= lo && ph < hi) { { int _wv = wave0; asm volatile("" : "+s"(_wv)); int _l; asm volatile("v_mbcnt_lo_u32_b32 %0, -1, 0\n\tv_mbcnt_hi_u32_b32 %0, -1, %0" : "=v"(_l)); F.wave = _wv; F.lane = _l; F.tid = _wv * 64 + _l; int _b = blockIdx.x; asm volatile("" : "+s"(_b)); F.bid = _b; unsigned char* _w = args.ws; asm volatile("" : "+s"(_w)); F.ws = _w; float* _o = args.out; asm volatile("" : "+s"(_o)); F.out = _o; } for (int rep = 0; rep < ((PROBE) == (grp) ? 2 : 1); ++rep) { if (rep) xcd_barrier(bar); __VA_ARGS__; } if (ph + 1 < hi) { if (ph == 0) grid.sync(); else xcd_barrier(bar); } } ++ph; } while (0)
#define TABP ((const float* const*)(F.ws + O_TAB))
#define WSC ((const char*)F.ws)
#define MODP ((float*)(F.ws + O_MOD))
#define XWP ((float*)(F.ws + O_XW))
    RUNG(1, phase_prep(F, TABP));
    RUNG(2, { Sched1 S{WSC + O_CS, WSC + O_ADAT, 1, 144, (size_t)256 * 1024 * 2, (size_t)256 * 1024 * 2, 16, F.G, F.bid}; EpiMod E{MODP, TABP[9]}; gemm_phase(F.lds, F.tid, 1024, 1024, 1024, S, E); });
#if PROBE == 14
    for (int q = 0; q < 20; ++q) xcd_barrier(bar);
#endif
    for (int layer = 0; layer < 4; ++layer) {
        const int j = layer >> 1;
        for (int s = 0; s < 3; ++s) {
            if (s != 1) {
                const int f = s >> 1, mi = s == 0 ? 0 : 6;
                RUNG(3, phase_norm(F, (layer == 0 && s == 0) ? TABP[0] : (const float*)(F.ws + O_XW), layer, mi, rep ? 0 : (s == 0 ? (layer == 0 ? 0 : 5) : 4)));
                RUNG(4, { Sched1 S{WSC + O_HB, WSC + O_WFI + (size_t)(layer * 2 + f) * SZ_WFI1, MT / 256, 22, (size_t)256 * 1024 * 2, (size_t)256 * 1024 * 2, 16, F.G, F.bid}; EpiSwiglu E{(bf16_t*)(F.ws + O_ACT)}; gemm_phase<true>(F.lds, F.tid, 1024, 1024, 1024, S, E); });
                RUNG(5, { SchedResid S{WSC + O_ACT, WSC + O_WFO + (size_t)(layer * 2 + f) * SZ_WFO1, DFF, rep ? 0 : 5, F.G, F.bid}; EpiResid E{XWP, (layer == 0 && s == 0) ? TABP[0] : (const float*)XWP, (float*)(F.ws + O_PART), MODP + layer * NMODC + (mi + 2) * D, rep ? 0.f : 0.5f}; gemm_phase(F.lds, F.tid, DFF, DFF, DFF, S, E); });
            } else if ((layer & 1) == 0) {
                RUNG(3, phase_norm(F, (const float*)(F.ws + O_XW), layer, 3, rep ? 0 : 5));
                RUNG(6, { Sched1 S{WSC + O_HB, WSC + O_WLI + (size_t)j * 2 * SZ_W1M, MT / 256, 8, (size_t)256 * 1024 * 2, (size_t)256 * 1024 * 2, 16, F.G, F.bid}; EpiLruIn E{(bf16_t*)(F.ws + O_GG), (float*)(F.ws + O_REC)}; gemm_phase(F.lds, F.tid, 1024, 1024, 1024, S, E); });
                RUNG(7, phase_conv(F, TABP, j));
                RUNG(8, { SchedGate S{WSC + O_XC, WSC + O_WLG + (size_t)j * SZ_WLG1, F.G, F.bid}; EpiLruGate E{(float*)(F.ws + O_AA), (float*)(F.ws + O_UU), (const bf16_t*)(F.ws + O_XC), TABP[16] + (size_t)j * 4 * 512, TABP[17] + (size_t)j * D}; gemm_phase(F.lds, F.tid, 1024, 256, 256, S, E); });
                RUNG(9, phase_scan_a(F));
                RUNG(9, phase_scan_b(F, TABP, j));
                RUNG(10, { SchedResid S{WSC + O_HB, WSC + O_WLO + (size_t)j * SZ_W1M, 1024, rep ? 0 : 4, F.G, F.bid}; EpiResid E{XWP, (const float*)XWP, (float*)(F.ws + O_PART), MODP + layer * NMODC + 5 * D, rep ? 0.f : 1.f}; gemm_phase(F.lds, F.tid, 1024, 1024, 1024, S, E); });
            } else {
                RUNG(3, phase_norm_rwkv(F, TABP, layer, j, rep ? 0 : 5));
                RUNG(11, { SchedRkv S{WSC + O_XM, WSC + O_WRKV + (size_t)j * 3 * SZ_W1M, WSC + O_WL1 + (size_t)j * SZ_WL1, j == 0 ? 6 : 7, F.G, F.bid}; EpiRkv E{(bf16_t*)(F.ws + O_R), (bf16_t*)(F.ws + O_K), (float*)(F.ws + O_V), (bf16_t*)(F.ws + O_VF), (bf16_t*)(F.ws + O_ACAT), j == 0 ? 1 : 0}; gemm_phase(F.lds, F.tid, 1024, 1024, 1024, S, E); });
                RUNG(12, { Sched1 S{WSC + O_ACAT, WSC + O_WL2 + (size_t)j * SZ_WL2, MT / 256, j == 0 ? 12 : 16, (size_t)256 * 384 * 2, (size_t)256 * 384 * 2, 6, F.G, F.bid}; EpiLora2 E{(float*)(F.ws + O_WD), (float*)(F.ws + O_AS), (float*)(F.ws + O_GS), (float*)(F.ws + O_V), (const bf16_t*)(F.ws + O_VF), TABP[22] + (size_t)j * D, TABP[25] + (size_t)j * D, TABP[28], rep}; gemm_phase(F.lds, F.tid, 384, 384, 384, S, E); });
                RUNG(13, phase_wkv(F, TABP, j));
                RUNG(10, { SchedResid S{WSC + O_HB, WSC + O_WO + (size_t)j * SZ_W1M, 1024, rep ? 0 : 4, F.G, F.bid}; EpiResid E{XWP, (const float*)XWP, (float*)(F.ws + O_PART), MODP + layer * NMODC + 5 * D, rep ? 0.f : 1.f}; gemm_phase(F.lds, F.tid, 1024, 1024, 1024, S, E); });
            }
        }
    }
    RUNG(3, phase_final(F, TABP, rep ? 0 : 5));
#undef RUNG
}

extern "C" void kernel_launch(void* const* d_in, const int* in_sizes, int n_in, void* d_out, int out_size, void* d_ws, size_t ws_size, hipStream_t stream) {
    static int grid = 0;
    if (grid == 0) {
        if (n_in != 39 || ws_size < WS_END) { fprintf(stderr, "kernel_launch: unexpected n_in %d / ws_size %zu (need %zu)\n", n_in, ws_size, (size_t)WS_END); grid = -1; return; }
        int dev = 0, cus = 0, per_cu = 0;
        hipGetDevice(&dev); hipDeviceGetAttribute(&cus, hipDeviceAttributeMultiprocessorCount, dev);
        if (hipFuncSetAttribute((const void*)mk_fwd, hipFuncAttributeMaxDynamicSharedMemorySize, LDS_BYTES) != hipSuccess) { fprintf(stderr, "kernel_launch: hipFuncSetAttribute failed\n"); grid = -1; return; }
        if (hipOccupancyMaxActiveBlocksPerMultiprocessor(&per_cu, (const void*)mk_fwd, 512, LDS_BYTES) != hipSuccess || per_cu < 1) { fprintf(stderr, "kernel_launch: occupancy query says %d\n", per_cu); per_cu = 1; }
        (void)hipGetLastError();
        grid = cus;
    }
    if (grid < 0) return;
    Args a{};
    for (int i = 0; i < 39; ++i) a.in[i] = (const float*)d_in[i];
    a.out = (float*)d_out; a.ws = (unsigned char*)d_ws;
#if MK_COOP
    if (hipMemsetAsync((char*)d_ws + O_BAR, 0, (size_t)3456 * 4, stream) != hipSuccess) { fprintf(stderr, "kernel_launch: memset failed\n"); return; }
    a.lo = 0; a.hi = NPH;
    void* kargs[] = {&a};
    hipError_t e = hipLaunchCooperativeKernel((const void*)mk_fwd, dim3(grid), dim3(512), kargs, LDS_BYTES, stream);
    if (e != hipSuccess) fprintf(stderr, "cooperative launch failed: %s (grid %d)\n", hipGetErrorString(e), grid);
#else
    for (int p = 0; p < NPH; ++p) { a.lo = p; a.hi = p + 1; hipLaunchKernelGGL(mk_fwd, dim3(grid), dim3(512), LDS_BYTES, stream, a); }
#endif
}
```

```cpp
#include <hip/hip_runtime.h>
#include <hip/hip_cooperative_groups.h>
#include <cstdio>
#include <cstdint>
namespace cg = cooperative_groups;

#ifndef PROBE
#define PROBE 0
#endif
#ifndef MK_COOP
#define MK_COOP 1
#endif

#define LAS __attribute__((address_space(3)))
#define GAS __attribute__((address_space(1)))
typedef unsigned short bf16_t;
typedef short bf16x8 __attribute__((ext_vector_type(8)));
typedef float f32x4 __attribute__((ext_vector_type(4)));
typedef float f32x2 __attribute__((ext_vector_type(2)));
typedef unsigned u32x2 __attribute__((ext_vector_type(2)));
typedef unsigned u32x4 __attribute__((ext_vector_type(4)));

constexpr int D = 1024, MP = 16384, MS = 1024, MT = MP + MS;
constexpr int DFF = 2816, NMODC = 9 * D, NCB = 136;
constexpr int LDS_BYTES = 144 * 1024;

constexpr size_t MD4 = (size_t)MT * D * 4, MD2 = MD4 / 2;
constexpr size_t SZ_WFI1 = (size_t)5632 * 1024 * 2, SZ_WFO1 = (size_t)1024 * 2816 * 2, SZ_W1M = (size_t)1024 * 1024 * 2;
constexpr size_t SZ_WLG1 = (size_t)4 * 512 * 256 * 2, SZ_WL1 = (size_t)4 * 256 * 1024 * 2, SZ_WL2 = (size_t)4096 * 384 * 2;
constexpr size_t O_WFI = 0;
constexpr size_t O_WFO = O_WFI + 8 * SZ_WFI1;
constexpr size_t O_WLI = O_WFO + 8 * SZ_WFO1;
constexpr size_t O_WLG = O_WLI + 2 * 2 * SZ_W1M;
constexpr size_t O_WLO = O_WLG + 2 * SZ_WLG1;
constexpr size_t O_WRKV = O_WLO + 2 * SZ_W1M;
constexpr size_t O_WO = O_WRKV + 6 * SZ_W1M;
constexpr size_t O_WL1 = O_WO + 2 * SZ_W1M;
constexpr size_t O_WL2 = O_WL1 + 2 * SZ_WL1;
constexpr size_t O_XW = O_WL2 + 2 * SZ_WL2;
constexpr size_t O_HB = O_XW + MD4;
constexpr size_t O_VF = O_HB + MD2;
constexpr size_t O_MOD = O_VF + MD2;
constexpr size_t SZ_MOD = (size_t)NCB * 4 * NMODC * 4;
constexpr size_t O_CS = O_MOD + SZ_MOD;
constexpr size_t O_AGG = O_CS + (size_t)256 * 1024 * 2;
constexpr size_t O_U = O_AGG + (size_t)8 * 16 * 1024 * 8;
constexpr size_t O_ADAT = O_U;
constexpr size_t O_ACT = O_U;
constexpr size_t O_GG = O_U, O_REC = O_U + MD2, O_XC = O_REC + MD4, O_AA = O_XC + MD2, O_UU = O_AA + MD4;
constexpr size_t O_XM = O_U, O_WD = O_U, O_AS = O_U + MD4, O_GS = O_U + 2 * MD4;
constexpr size_t O_R = O_U + 6 * MD2, O_K = O_R + MD2, O_V = O_K + MD2, O_ACAT = O_V + MD4;
constexpr size_t O_TAB = O_ACAT + (size_t)MT * 384 * 2;
constexpr size_t O_BAR = O_TAB + 512;
constexpr size_t O_PART = O_BAR + 16384;
constexpr size_t PART_SLAB = (size_t)MS * D * 4;
constexpr size_t O_XB = O_PART + 5 * PART_SLAB;
constexpr size_t WS_END = O_XB + (size_t)128 * 2 * 8 * 32 * 8;
static_assert(WS_END <= (size_t)738197504, "workspace too large");
static_assert(O_UU + MD4 <= O_ACAT, "lru overlay");

constexpr size_t OUT_Y = 0;
constexpr size_t OUT_P_H = (size_t)MT * D;
constexpr size_t OUT_P_CONV = OUT_P_H + 2 * 8 * 1024;
constexpr size_t OUT_P_SHIFT = OUT_P_CONV + 2 * 8 * 3 * 1024;
constexpr size_t OUT_P_WKV = OUT_P_SHIFT + 2 * 8 * 1024;
constexpr size_t OUT_S_H = OUT_P_WKV + (size_t)2 * 8 * 16 * 4096;
constexpr size_t OUT_S_CONV = OUT_S_H + 2 * 128 * 1024;
constexpr size_t OUT_S_SHIFT = OUT_S_CONV + 2 * 128 * 3 * 1024;
constexpr size_t OUT_S_WKV = OUT_S_SHIFT + 2 * 128 * 1024;

struct Args { const float* in[39]; float* out; unsigned char* ws; int lo, hi; };

__device__ __forceinline__ unsigned cvt_pk_bf16(float lo, float hi) { unsigned r; asm volatile("v_cvt_pk_bf16_f32 %0, %1, %2" : "=v"(r) : "v"(lo), "v"(hi)); return r; }
__device__ __forceinline__ float bf_lo(unsigned u) { return __uint_as_float(u << 16); }
__device__ __forceinline__ float bf_hi(unsigned u) { return __uint_as_float(u & 0xffff0000u); }
__device__ __forceinline__ float frcp(float x) { return __builtin_amdgcn_rcpf(x); }
__device__ __forceinline__ float fsigmoid(float x) { return frcp(1.f + __expf(-x)); }
__device__ __forceinline__ float ftanh(float x) { return 1.f - 2.f * frcp(1.f + __expf(2.f * x)); }
__device__ __forceinline__ float fsilu(float x) { return x * fsigmoid(x); }
__device__ __forceinline__ float fgelu(float x) { return 0.5f * x * (1.f + ftanh(0.7978845608028654f * (x + 0.044715f * x * x * x))); }
__device__ __forceinline__ int cb_of(int row) { return row < MP ? (row >> 11) : 8 + ((row - MP) >> 3); }
template <int CTRL> __device__ __forceinline__ float dpp_f(float v) { return __int_as_float(__builtin_amdgcn_update_dpp(0, __float_as_int(v), CTRL, 0xF, 0xF, true)); }
__device__ __forceinline__ float sum8(float v) {
    v += dpp_f<0xB1>(v);
    v += dpp_f<0x4E>(v);
    v += dpp_f<0x141>(v);
    return v;
}

__device__ __forceinline__ float row16_sum(float v) {
    v += dpp_f<0xB1>(v); v += dpp_f<0x4E>(v); v += dpp_f<0x141>(v); v += dpp_f<0x140>(v); return v;
}
__device__ __forceinline__ float xor_shfl(float v, int lane, int o) { return __int_as_float(__builtin_amdgcn_ds_bpermute((lane ^ o) << 2, __float_as_int(v))); }
__device__ __forceinline__ float wave_sum(float v, int lane) { v = row16_sum(v); v += xor_shfl(v, lane, 16); v += xor_shfl(v, lane, 32); return v; }
__device__ __forceinline__ float half_sum(float v, int lane) { v = row16_sum(v); v += xor_shfl(v, lane, 16); return v; }

constexpr int BM = 256, BK = 64, HALF = 128, HTB = HALF * BK * 2, NXCD = 8, WGM = 8;
__device__ __forceinline__ int lds_byte(int r, int c) { const int st = (r >> 4) * 2 + (c >> 5), rr = r & 15, cc = c & 31, ob = rr * 64 + cc * 2; return st * 1024 + (ob ^ (((ob >> 9) & 1) << 5)); }
__device__ __forceinline__ void stage_rc(int b, int& R, int& C) { const int st = b / 1024, sb = b % 1024, swz = sb ^ (((sb >> 9) & 1) << 5); R = (st >> 1) * 16 + swz / 64; C = (st & 1) * 32 + (swz % 64) / 2; }

__device__ __forceinline__ int perm32(int rho) { const int n = rho >> 4, i = rho & 15; return 8 * (i >> 2) + 4 * n + (i & 3); }
struct Unit { const char* a; const char* b; int pm, pn, gi, nt; };
__device__ __forceinline__ void tile_of(int wgid, int nM, int nN, int& pm, int& pn) {
    const int nwg = nM * nN;
    { const int q = nwg / NXCD, r = nwg % NXCD, xcd = wgid % NXCD, off = wgid / NXCD; wgid = (xcd < r ? xcd * (q + 1) : r * (q + 1) + (xcd - r) * q) + off; }
    const int nig = WGM * nN, gid = wgid / nig, fm = gid * WGM, gsz = (nM - fm) < WGM ? (nM - fm) : WGM;
    pm = fm + ((wgid % nig) % gsz); pn = (wgid % nig) / gsz;
}
struct Sched1 {
    const char* A; const char* B; int nM, nN; size_t tA, tB; int nt, G, c;
    __device__ __forceinline__ bool next(int i, Unit& u) const {
        const long L = (long)i * G + c; if (L >= (long)nM * nN) return false;
        tile_of((int)L, nM, nN, u.pm, u.pn); u.gi = 0; u.nt = nt; u.a = A + (size_t)u.pm * tA; u.b = B + (size_t)u.pn * tB; return true;
    }
};
struct SchedResid {
    const char* A; const char* B; int ldk, S, G, c;
    __device__ __forceinline__ bool next(int i, Unit& u) const {
        const int nsplit = 16 * S;
        long L = (long)i * G + c;
        if (G == 256 && c < nsplit) { if (i == 0) L = 256 + c; else if (i == 1) L = c; else return false; }
        if (L < 256) { tile_of((int)L, 64, 4, u.pm, u.pn); u.gi = 0; u.nt = ldk / 64; u.a = A + (size_t)u.pm * 512 * ldk; u.b = B + (size_t)u.pn * 512 * ldk; return true; }
        const int idx = (int)L - 256; if (idx >= nsplit) return false;
        const int tile = idx / S, ks = idx % S; u.pm = 64 + (tile >> 2); u.pn = tile & 3; u.gi = 1 + ks;
        const int pairs = ldk / 128, base = 2 * (pairs / S), rem = pairs % S, start = ks * base + 2 * (ks < rem ? ks : rem);
        u.nt = base + (ks < rem ? 2 : 0);
        u.a = A + (size_t)u.pm * 512 * ldk + (size_t)start * 128; u.b = B + (size_t)u.pn * 512 * ldk + (size_t)start * 128; return true;
    }
};
struct SchedRkv {
    const char* XM; const char* WR; const char* WL; int ng; int G, c;
    __device__ __forceinline__ bool next(int i, Unit& u) const {
        const long L = (long)i * G + c; constexpr int nM = MT / 256, BIG = nM * 4;
        if (L >= 3 * BIG + (ng - 3) * nM) return false;
        int gi, l, nN;
        if (L < 3 * BIG) { gi = (int)L / BIG; l = (int)L % BIG; nN = 4; } else { const int r = (int)L - 3 * BIG; gi = 3 + r / nM; l = r % nM; nN = 1; }
        tile_of(l, nM, nN, u.pm, u.pn); u.gi = gi; u.nt = 16;
        const int ai = gi < 3 ? gi : (gi == 6 ? 2 : gi);
        u.a = XM + (size_t)ai * MD2 + (size_t)u.pm * (256 * 1024 * 2);
        u.b = (gi < 3 ? WR + (size_t)gi * SZ_W1M : WL + (size_t)(gi - 3) * (256 * 1024 * 2)) + (size_t)u.pn * (256 * 1024 * 2);
        return true;
    }
};
struct SchedGate {
    const char* XC; const char* WG; int G, c;
    __device__ __forceinline__ bool next(int i, Unit& u) const {
        const long L = (long)i * G + c; constexpr int nM = MT / 256, PER = nM * 2;
        if (L >= 4 * PER) return false;
        const int gi = (int)L / PER, l = (int)L % PER;
        tile_of(l, nM, 2, u.pm, u.pn); u.gi = gi; u.nt = 4;
        u.a = XC + (size_t)gi * 512 + (size_t)u.pm * (256 * 1024 * 2);
        u.b = WG + (size_t)gi * (512 * 256 * 2) + (size_t)u.pn * (256 * 256 * 2);
        return true;
    }
};

template <bool PERM = false, class Epi, class Sched>
__device__ __forceinline__ void gemm_phase(LAS unsigned char* lds, const int tid, const int lda, const int ldb, const int K, const Sched& S, const Epi& E) {
    const int wid = __builtin_amdgcn_readfirstlane(tid >> 6), lane = tid & 63, wr = wid >> 2, wc = wid & 3, fr = lane & 15, fq = lane >> 4;
    unsigned voffA[2], voffB[2];
#pragma unroll
    for (int i = 0; i < 2; ++i) { int R, C; stage_rc(tid * 16 + i * 8192, R, C); const int Rb = PERM ? ((R & ~31) + perm32(R & 31)) : R; voffA[i] = (unsigned)(R * lda + C) * 2u; voffB[i] = (unsigned)(Rb * ldb + C) * 2u; }
    const size_t kstep = (size_t)(BK * 2);
    const size_t hstepA = (size_t)HALF * lda * 2, hstepB = (size_t)HALF * ldb * 2;
    const unsigned ldsw = (unsigned)wid * 1024u;
    const int aoff = lds_byte(wr * 64 + fr, fq * 8), boff = lds_byte(wc * 32 + fr, fq * 8);
#define PG8_SA(b, h) (((b) * 2 + (h)) * HTB)
#define PG8_SB(b, h) ((4 + (b) * 2 + (h)) * HTB)
#define PG8_STAGE(bufoff, gbase, voff) do { _Pragma("unroll") for (int _i = 0; _i < 2; ++_i) \
        __builtin_amdgcn_global_load_lds((const unsigned*)((const char*)(gbase) + (voff)[_i]), (LAS unsigned*)(lds + (bufoff) + ldsw + _i * 8192), 16, 0, 0); } while (0)
#define PG8_LDA(dst, b, h) do { _Pragma("unroll") for (int m = 0; m < 4; ++m) _Pragma("unroll") for (int k = 0; k < 2; ++k) dst[m][k] = *(const LAS bf16x8*)(lds + PG8_SA(b, h) + aoff + m * 2048 + k * 1024); } while (0)
#define PG8_LDB(dst, b, h) do { _Pragma("unroll") for (int n = 0; n < 2; ++n) _Pragma("unroll") for (int k = 0; k < 2; ++k) dst[n][k] = *(const LAS bf16x8*)(lds + PG8_SB(b, h) + boff + n * 2048 + k * 1024); } while (0)
#define PG8_MMA(ai, bj, At, Bt) do { __builtin_amdgcn_s_setprio(1); _Pragma("unroll") for (int m = 0; m < 4; ++m) _Pragma("unroll") for (int n = 0; n < 2; ++n) _Pragma("unroll") for (int k = 0; k < 2; ++k) \
        acc[ai][bj][m][n] = __builtin_amdgcn_mfma_f32_16x16x32_bf16(Bt[n][k], At[m][k], acc[ai][bj][m][n], 0, 0, 0); __builtin_amdgcn_s_setprio(0); } while (0)
#define PG8_WAIT_V(n) asm volatile("s_waitcnt vmcnt(" #n ")" ::: "memory")
#define PG8_WAIT_L(n) asm volatile("s_waitcnt lgkmcnt(" #n ")" ::: "memory")
#define PG8_BAR __builtin_amdgcn_s_barrier()
#define PG8_SCHED __builtin_amdgcn_sched_barrier(0)
    Unit cur, nxt; int ui = 0;
    if (!S.next(0, cur)) return;
    f32x4 acc[2][2][4][2];
#pragma unroll
    for (int a = 0; a < 2; ++a)
#pragma unroll
        for (int b = 0; b < 2; ++b)
#pragma unroll
            for (int m = 0; m < 4; ++m)
#pragma unroll
                for (int n = 0; n < 2; ++n) acc[a][b][m][n] = (f32x4){0.f, 0.f, 0.f, 0.f};
    bf16x8 At[4][2], B0[2][2], B1[2][2];
    const char* cA = cur.a; const char* cB = cur.b;
    PG8_STAGE(PG8_SB(0, 0), cB, voffB); PG8_STAGE(PG8_SA(0, 0), cA, voffA); PG8_STAGE(PG8_SB(0, 1), cB + hstepB, voffB); PG8_STAGE(PG8_SA(0, 1), cA + hstepA, voffA);
    if (wr == 1) PG8_BAR;
    PG8_WAIT_V(4); PG8_BAR;
    PG8_STAGE(PG8_SB(1, 0), cB + kstep, voffB); PG8_STAGE(PG8_SA(1, 0), cA + kstep, voffA); PG8_STAGE(PG8_SB(1, 1), cB + hstepB + kstep, voffB);
    PG8_WAIT_V(6); PG8_BAR;
    for (;;) {
        const bool has_next = S.next(ui + 1, nxt);
        const char* nA = has_next ? nxt.a : cA; const char* nB = has_next ? nxt.b : cB;
        const int nt = cur.nt;
        for (int t = 0; t < nt; t += 2) {
            const bool last = (t == nt - 2);
            const char* a1 = cA + (size_t)(t + 1) * kstep;
            const char* a2 = last ? nA : cA + (size_t)(t + 2) * kstep; const char* b2 = last ? nB : cB + (size_t)(t + 2) * kstep;
            const char* a3 = a2 + kstep; const char* b3 = b2 + kstep;
            PG8_LDB(B0, 0, 0); PG8_SCHED; PG8_LDA(At, 0, 0); PG8_STAGE(PG8_SA(1, 1), a1 + hstepA, voffA);
            PG8_WAIT_L(8); PG8_BAR; PG8_WAIT_L(0); PG8_MMA(0, 0, At, B0); PG8_BAR; PG8_SCHED;
            PG8_LDB(B1, 0, 1); PG8_STAGE(PG8_SB(0, 0), b2, voffB);
            PG8_BAR; PG8_WAIT_L(0); PG8_MMA(0, 1, At, B1); PG8_BAR;
            PG8_LDA(At, 0, 1); PG8_STAGE(PG8_SA(0, 0), a2, voffA);
            PG8_BAR; PG8_WAIT_L(0); PG8_MMA(1, 0, At, B0); PG8_BAR; PG8_SCHED;
            PG8_STAGE(PG8_SB(0, 1), b2 + hstepB, voffB);
            PG8_WAIT_V(6); PG8_BAR; PG8_MMA(1, 1, At, B1); PG8_BAR;
            PG8_LDB(B0, 1, 0); PG8_SCHED; PG8_LDA(At, 1, 0); PG8_STAGE(PG8_SA(0, 1), a2 + hstepA, voffA);
            PG8_WAIT_L(8); PG8_BAR; PG8_WAIT_L(0); PG8_MMA(0, 0, At, B0); PG8_BAR; PG8_SCHED;
            PG8_LDB(B1, 1, 1); PG8_STAGE(PG8_SB(1, 0), b3, voffB);
            PG8_BAR; PG8_WAIT_L(0); PG8_MMA(0, 1, At, B1); PG8_BAR;
            PG8_LDA(At, 1, 1); PG8_STAGE(PG8_SA(1, 0), a3, voffA);
            PG8_BAR; PG8_WAIT_L(0); PG8_MMA(1, 0, At, B0); PG8_BAR; PG8_SCHED;
            PG8_STAGE(PG8_SB(1, 1), b3 + hstepB, voffB);
            PG8_WAIT_V(6); PG8_BAR; PG8_MMA(1, 1, At, B1); PG8_BAR;
        }
        E(acc, cur, wr, wc, fr, fq);
        if (!has_next) break;
#pragma unroll
        for (int a = 0; a < 2; ++a)
#pragma unroll
            for (int b = 0; b < 2; ++b)
#pragma unroll
                for (int m = 0; m < 4; ++m)
#pragma unroll
                    for (int n = 0; n < 2; ++n) acc[a][b][m][n] = (f32x4){0.f, 0.f, 0.f, 0.f};
        cur = nxt; cA = nA; cB = nB; ++ui;
    }
    PG8_WAIT_V(0);
    if (wr == 0) PG8_BAR;
    PG8_BAR;
#undef PG8_SA
#undef PG8_SB
#undef PG8_STAGE
#undef PG8_LDA
#undef PG8_LDB
#undef PG8_MMA
#undef PG8_WAIT_V
#undef PG8_WAIT_L
#undef PG8_BAR
#undef PG8_SCHED
}

typedef f32x4 AccT[2][2][4][2];
#define EPI_LOOP_ROWS for (int ai = 0; ai < 2; ++ai) for (int m = 0; m < 4; ++m)
#define EPI_LOOP_COLS for (int bj = 0; bj < 2; ++bj) for (int n = 0; n < 2; ++n)

struct EpiMod {
    float* MOD; const float* bias;
    __device__ __forceinline__ void operator()(const AccT& acc, const Unit& u, int wr, int wc, int fr, int fq) const {
        const int row0 = wr * 64 + fr, col0 = u.pn * 256 + wc * 32 + 4 * fq;
#pragma unroll
        EPI_LOOP_ROWS { const int row = row0 + ai * 128 + m * 16; if (row < NCB) {
#pragma unroll
            EPI_LOOP_COLS { const int col = col0 + bj * 128 + n * 16; *(f32x4*)(MOD + (size_t)row * (4 * NMODC) + col) = acc[ai][bj][m][n] + *(const f32x4*)(bias + col); } } }
    }
};
struct EpiResid {
    float* X; const float* XR; float* PART; const float* modg; float coef;
    __device__ __forceinline__ void operator()(const AccT& acc, const Unit& u, int wr, int wc, int fr, int fq) const {
        const int row0 = u.pm * 256 + wr * 64 + fr, col0 = u.pn * 256 + wc * 32 + 4 * fq;
#pragma unroll
        EPI_LOOP_ROWS { const int row = row0 + ai * 128 + m * 16; const float* gp = modg + (size_t)cb_of(row) * (4 * NMODC) + col0;
            float* xp = u.gi == 0 ? X + (size_t)row * D + col0 : PART + (size_t)(u.gi - 1) * (MS * D) + (size_t)(row - MP) * D + col0;
#pragma unroll
            EPI_LOOP_COLS { const int o = bj * 128 + n * 16; const f32x4 g = *(const f32x4*)(gp + o); f32x4 d = (g + 1.f) * coef * acc[ai][bj][m][n];
                if (u.gi == 0) d += *(const f32x4*)(XR + (size_t)row * D + col0 + o);
                *(f32x4*)(xp + o) = d; } }
    }
};
struct EpiSwiglu {
    bf16_t* ACT;
    __device__ __forceinline__ void operator()(const AccT& acc, const Unit& u, int wr, int wc, int fr, int fq) const {
        const int row0 = u.pm * 256 + wr * 64 + fr, col0 = u.pn * 128 + wc * 32 + 8 * fq;
#pragma unroll
        EPI_LOOP_ROWS { bf16_t* op = ACT + (size_t)(row0 + ai * 128 + m * 16) * DFF + col0;
            const f32x4 g0 = acc[ai][0][m][0], v0 = acc[ai][1][m][0], g1 = acc[ai][0][m][1], v1 = acc[ai][1][m][1];
            u32x4 o; o.x = cvt_pk_bf16(fsilu(g0.x) * v0.x, fsilu(g0.y) * v0.y); o.y = cvt_pk_bf16(fsilu(g0.z) * v0.z, fsilu(g0.w) * v0.w);
            o.z = cvt_pk_bf16(fsilu(g1.x) * v1.x, fsilu(g1.y) * v1.y); o.w = cvt_pk_bf16(fsilu(g1.z) * v1.z, fsilu(g1.w) * v1.w);
            *(u32x4*)op = o; }
    }
};
struct EpiLruIn {
    bf16_t* GG; float* REC;
    __device__ __forceinline__ void operator()(const AccT& acc, const Unit& u, int wr, int wc, int fr, int fq) const {
        const int row0 = u.pm * 256 + wr * 64 + fr, col0 = (u.pn & 3) * 256 + wc * 32 + 4 * fq;
        if (u.pn < 4) {
#pragma unroll
            EPI_LOOP_ROWS { bf16_t* op = GG + (size_t)(row0 + ai * 128 + m * 16) * D + col0;
#pragma unroll
                EPI_LOOP_COLS { const f32x4 v = acc[ai][bj][m][n]; u32x2 o; o.x = cvt_pk_bf16(fgelu(v.x), fgelu(v.y)); o.y = cvt_pk_bf16(fgelu(v.z), fgelu(v.w)); *(u32x2*)(op + bj * 128 + n * 16) = o; } }
        } else {
#pragma unroll
            EPI_LOOP_ROWS { float* op = REC + (size_t)(row0 + ai * 128 + m * 16) * D + col0;
#pragma unroll
                EPI_LOOP_COLS *(f32x4*)(op + bj * 128 + n * 16) = acc[ai][bj][m][n]; }
        }
    }
};
struct EpiLruGate {
    float* AA; float* UU; const bf16_t* XC; const float* gate_b; const float* lam;
    __device__ __forceinline__ void operator()(const AccT& acc, const Unit& u, int wr, int wc, int fr, int fq) const {
        const int row0 = u.pm * 256 + wr * 64 + fr, cl = u.pn * 128 + wc * 32 + 4 * fq, ch0 = u.gi * 256 + cl;
#pragma unroll
        for (int n = 0; n < 2; ++n) {
            const f32x4 br = *(const f32x4*)(gate_b + u.gi * 512 + cl + n * 16), bi = *(const f32x4*)(gate_b + u.gi * 512 + 256 + cl + n * 16);
            const f32x4 lm = *(const f32x4*)(lam + ch0 + n * 16); f32x4 ls;
#pragma unroll
            for (int e = 0; e < 4; ++e) { const float x = __expf(-lm[e]); ls[e] = -8.f * x * (1.f - x * (0.5f - x * (0.33333333f - 0.25f * x))); }
#pragma unroll
            EPI_LOOP_ROWS { const size_t ro = (size_t)(row0 + ai * 128 + m * 16) * D + ch0 + n * 16;
                const u32x2 xb = *(const u32x2*)(XC + ro);
                const f32x4 xv = (f32x4){bf_lo(xb.x), bf_hi(xb.x), bf_lo(xb.y), bf_hi(xb.y)};
                f32x4 av, uv;
#pragma unroll
                for (int e = 0; e < 4; ++e) { const float r = fsigmoid(acc[ai][0][m][n][e] + br[e]), ig = fsigmoid(acc[ai][1][m][n][e] + bi[e]);
                    const float a1 = __expf(r * ls[e]); av[e] = a1; uv[e] = sqrtf(fmaxf(1.f - a1 * a1, 0.f)) * ig * xv[e]; }
                *(f32x4*)(AA + ro) = av; *(f32x4*)(UU + ro) = uv; } }
    }
};
struct EpiRkv {
    bf16_t* R; bf16_t* Kb; float* V; bf16_t* VF; bf16_t* ACAT; int write_vf;
    __device__ __forceinline__ void operator()(const AccT& acc, const Unit& u, int wr, int wc, int fr, int fq) const {
        const int row0 = u.pm * 256 + wr * 64 + fr, col0 = u.pn * 256 + wc * 32 + 4 * fq;
        if (u.gi < 2) { bf16_t* O = u.gi == 0 ? R : Kb;
#pragma unroll
            EPI_LOOP_ROWS { bf16_t* op = O + (size_t)(row0 + ai * 128 + m * 16) * D + col0;
#pragma unroll
                EPI_LOOP_COLS { const f32x4 v = acc[ai][bj][m][n]; u32x2 o; o.x = cvt_pk_bf16(v.x, v.y); o.y = cvt_pk_bf16(v.z, v.w); *(u32x2*)(op + bj * 128 + n * 16) = o; } }
        } else if (u.gi == 2) {
#pragma unroll
            EPI_LOOP_ROWS { const size_t ro = (size_t)(row0 + ai * 128 + m * 16) * D + col0;
#pragma unroll
                EPI_LOOP_COLS { const f32x4 v = acc[ai][bj][m][n]; *(f32x4*)(V + ro + bj * 128 + n * 16) = v;
                    if (write_vf) { u32x2 o; o.x = cvt_pk_bf16(v.x, v.y); o.y = cvt_pk_bf16(v.z, v.w); *(u32x2*)(VF + ro + bj * 128 + n * 16) = o; } } }
        } else {
            const int nv = u.gi == 5 ? 160 : (u.gi == 6 ? 32 : 64), cbase = u.gi == 3 ? 0 : (u.gi == 4 ? 64 : (u.gi == 5 ? 128 : 288));
#pragma unroll
            EPI_LOOP_ROWS { bf16_t* op = ACAT + (size_t)(row0 + ai * 128 + m * 16) * 384 + cbase;
#pragma unroll
                EPI_LOOP_COLS { const int col = col0 + bj * 128 + n * 16; if (col < nv) { f32x4 v = acc[ai][bj][m][n];
                    if (u.gi == 3) { v.x = ftanh(v.x); v.y = ftanh(v.y); v.z = ftanh(v.z); v.w = ftanh(v.w); }
                    else if (u.gi == 5) { v.x = fsigmoid(v.x); v.y = fsigmoid(v.y); v.z = fsigmoid(v.z); v.w = fsigmoid(v.w); }
                    u32x2 o; o.x = cvt_pk_bf16(v.x, v.y); o.y = cvt_pk_bf16(v.z, v.w); *(u32x2*)(op + col) = o; } } }
        }
    }
};
struct EpiLora2 {
    float* WD; float* AS; float* GS; float* V; const bf16_t* VF; const float* w0; const float* a0; const float* v0; int skipv;
    __device__ __forceinline__ void operator()(const AccT& acc, const Unit& u, int wr, int wc, int fr, int fq) const {
        const int sec = u.pn >> 2, row0 = u.pm * 256 + wr * 64 + fr, col0 = (u.pn & 3) * 256 + wc * 32 + 4 * fq;
#pragma unroll
        EPI_LOOP_ROWS { const size_t ro = (size_t)(row0 + ai * 128 + m * 16) * D + col0;
#pragma unroll
            EPI_LOOP_COLS { const int o = bj * 128 + n * 16; const f32x4 v = acc[ai][bj][m][n]; f32x4 r;
                if (sec == 0) { const f32x4 b = *(const f32x4*)(w0 + col0 + o);
#pragma unroll
                    for (int e = 0; e < 4; ++e) r[e] = __expf(-0.6065306597f * fsigmoid(b[e] + v[e]));
                    *(f32x4*)(WD + ro + o) = r;
                } else if (sec == 1) { const f32x4 b = *(const f32x4*)(a0 + col0 + o);
#pragma unroll
                    for (int e = 0; e < 4; ++e) r[e] = fsigmoid(b[e] + v[e]);
                    *(f32x4*)(AS + ro + o) = r;
                } else if (sec == 2) { *(f32x4*)(GS + ro + o) = v;
                } else if (!skipv) { const f32x4 b = *(const f32x4*)(v0 + col0 + o); const f32x4 vr = *(const f32x4*)(V + ro + o); const u32x2 fb = *(const u32x2*)(VF + ro + o);
                    const float vf[4] = {bf_lo(fb.x), bf_hi(fb.x), bf_lo(fb.y), bf_hi(fb.y)};
#pragma unroll
                    for (int e = 0; e < 4; ++e) r[e] = vr[e] + (vf[e] - vr[e]) * fsigmoid(b[e] + v[e]);
                    *(f32x4*)(V + ro + o) = r; } } }
    }
};


#define XB_TMO      128
#define XB_XCNT(j)  (256  + 64 * (j))
#define XB_XSUB(j)  (1280 + 64 * (j))
#define XB_XGEN(j)  (2304 + 64 * (j))
#define XB_TOP      3328
#define XB_TOPGEN   3392
#define XCD_BAR_WORDS 3456
#define XB_SPIN_CAP (1u << 18)
__device__ __forceinline__ unsigned xb_ld(unsigned* p)              { return __hip_atomic_load(p, __ATOMIC_RELAXED, __HIP_MEMORY_SCOPE_AGENT); }
__device__ __forceinline__ unsigned xb_add(unsigned* p, unsigned v) { return __hip_atomic_fetch_add(p, v, __ATOMIC_RELAXED, __HIP_MEMORY_SCOPE_AGENT); }
__device__ __forceinline__ unsigned xb_xcc_id() { return (unsigned)__builtin_amdgcn_s_getreg((3 << 11) | 20) & 0xFu; }
#define XB_SPIN(cond, bar) do { unsigned _sp = 0; while (cond) { __builtin_amdgcn_s_sleep(1); \
    if ((++_sp & 255u) == 0u) { if (xb_ld(&(bar)[XB_TMO])) break; if (_sp > XB_SPIN_CAP) { atomicAdd(&(bar)[XB_TMO], 1u); break; } } } } while (0)
struct XcdBarrier { unsigned* bar; unsigned x; volatile LAS unsigned* st; };
__device__ __forceinline__ XcdBarrier xcd_barrier_post(unsigned* bar, volatile LAS unsigned* st) {
    XcdBarrier b; b.bar = bar; b.x = xb_xcc_id(); b.st = st;
    if (threadIdx.x == 0) (void)xb_add(&bar[XB_XCNT(b.x)], 1u);
    return b;
}
__device__ __forceinline__ void xcd_barrier_complete(unsigned* bar, unsigned x, unsigned& nloc, unsigned& nx) {
    const unsigned G = gridDim.x * gridDim.y * gridDim.z;
    unsigned sum, cnt, mine, sp = 0u;
    for (;;) {
        sum = 0u; cnt = 0u; mine = 0u;
#pragma unroll
        for (unsigned j = 0; j < 16; ++j) { const unsigned c = xb_ld(&bar[XB_XCNT(j)]); sum += c; cnt += (c > 0u) ? 1u : 0u; mine = (j == x) ? c : mine; }
        if (sum == G) break;
        __builtin_amdgcn_s_sleep(1);
        if ((++sp & 255u) == 0u) { if (xb_ld(&bar[XB_TMO])) break; if (sp > XB_SPIN_CAP) { atomicAdd(&bar[XB_TMO], 1u); break; } }
    }
    nloc = mine > 0u ? mine : 1u; nx = cnt > 0u ? cnt : 1u;
}
__device__ __forceinline__ void xcd_barrier(const XcdBarrier& b) {
    asm volatile("s_waitcnt vmcnt(0)" ::: "memory");
    __syncthreads();
    if (threadIdx.x == 0) {
        unsigned* bar = b.bar;
        __builtin_amdgcn_s_waitcnt(0);
        unsigned nloc = b.st[0], nx = b.st[1];
        if (nloc == 0u) { xcd_barrier_complete(bar, b.x, nloc, nx); b.st[0] = nloc; b.st[1] = nx; }
        const unsigned old = xb_add(&bar[XB_XSUB(b.x)], 1u);
        const unsigned gen = old / nloc;
        if (old + 1u == (gen + 1u) * nloc) {
            __builtin_amdgcn_fence(__ATOMIC_RELEASE, "agent");
            asm volatile("s_waitcnt vmcnt(0)" ::: "memory");
            const unsigned og = xb_add(&bar[XB_TOP], 1u);
            const unsigned tg = og / nx;
            if (og + 1u == (tg + 1u) * nx) xb_add(&bar[XB_TOPGEN], 1u);
            else XB_SPIN(xb_ld(&bar[XB_TOPGEN]) == tg, bar);
            __builtin_amdgcn_fence(__ATOMIC_ACQUIRE, "agent");
            xb_add(&bar[XB_XGEN(b.x)], 1u);
            asm volatile("s_waitcnt vmcnt(0)" ::: "memory");
        } else {
            XB_SPIN(xb_ld(&bar[XB_XGEN(b.x)]) == gen, bar);
            __builtin_amdgcn_fence(__ATOMIC_ACQUIRE, "agent");
            asm volatile("s_waitcnt vmcnt(0)" ::: "memory");
        }
    }
    __syncthreads();
}

struct Frame {
    LAS unsigned char* lds; unsigned char* ws; float* out;
    int tid, lane, wave, G, bid;
};

template <bool NTST = true>
__device__ __forceinline__ void tr_item(const float* __restrict__ src, int ldsrc, int Ks, int Ns, int k0s, int n0s, bf16_t* dst, int ldd, LAS float* scr, int lane) {
    f32x4 tv[16];
#pragma unroll
    for (int i = 0; i < 16; ++i) { const int k = 4 * i + (lane >> 4), n4 = (lane & 15) * 4, ks = k0s + k;
        tv[i] = (f32x4){0.f, 0.f, 0.f, 0.f};
        if (ks >= 0 && ks < Ks && n0s + n4 < Ns) tv[i] = __builtin_nontemporal_load((const GAS f32x4*)((const GAS float*)src + (size_t)ks * ldsrc + n0s + n4)); }
#pragma unroll
    for (int i = 0; i < 16; ++i) { const int k = 4 * i + (lane >> 4), n4 = (lane & 15) * 4; const f32x4 v = tv[i];
        scr[(n4 + 0) * 65 + k] = v.x; scr[(n4 + 1) * 65 + k] = v.y; scr[(n4 + 2) * 65 + k] = v.z; scr[(n4 + 3) * 65 + k] = v.w; }
    asm volatile("s_waitcnt lgkmcnt(0)" ::: "memory");
    const int c = lane & 7;
#pragma unroll
    for (int j = 0; j < 8; ++j) { const int n = (lane >> 3) + 8 * j; const LAS float* s = scr + n * 65 + 8 * c;
        u32x4 o; o.x = cvt_pk_bf16(s[0], s[1]); o.y = cvt_pk_bf16(s[2], s[3]); o.z = cvt_pk_bf16(s[4], s[5]); o.w = cvt_pk_bf16(s[6], s[7]);
        if (NTST) __builtin_nontemporal_store(o, (GAS u32x4*)((GAS bf16_t*)dst + (size_t)n * ldd + 8 * c)); else *(GAS u32x4*)((GAS bf16_t*)dst + (size_t)n * ldd + 8 * c) = o; }
    asm volatile("s_waitcnt lgkmcnt(0)" ::: "memory");
}
__device__ __forceinline__ int ilv_row(int n0, int H) { return n0 < H ? 256 * (n0 / 128) + (n0 % 128) : 256 * ((n0 - H) / 128) + 128 + ((n0 - H) % 128); }

__device__ __forceinline__ void phase_prep(Frame& F, const float* const* IN) {
    const float* const* in = IN;
    LAS float* scr = (LAS float*)(F.lds + F.wave * 16640);
    const int gw = F.bid * 8 + F.wave, NGW = F.G * 8;
    constexpr int I_FI = 8 * 16 * 88, I_FO = 8 * 44 * 16, I_LI = 2 * 16 * 32, I_LG = 8 * 4 * 8, I_LO = 2 * 256, I_RKV = 6 * 256, I_WO = 2 * 256, I_L1 = 2 * 4 * 16 * 4, I_L2 = 2 * 4 * 6 * 16, I_ADA = 4 * 16 * 144;
    constexpr int NITEMS = I_FI + I_FO + I_LI + I_LG + I_LO + I_RKV + I_WO + I_L1 + I_L2 + I_ADA;
    for (int it = gw; it < NITEMS; it += NGW) {
        int r = it;
        if (r < I_FI) { const int mtx = r / 1408, q = r % 1408, kb = q / 88, nb = q % 88;
            tr_item(in[10] + (size_t)mtx * 1024 * 5632, 5632, 1024, 5632, 64 * kb, 64 * nb, (bf16_t*)(F.ws + O_WFI + mtx * SZ_WFI1) + (size_t)ilv_row(64 * nb, 2816) * 1024 + 64 * kb, 1024, scr, F.lane); continue; } r -= I_FI;
        if (r < I_FO) { const int mtx = r / 704, q = r % 704, kb = q / 16, nb = q % 16;
            tr_item(in[11] + (size_t)mtx * 2816 * 1024, 1024, 2816, 1024, 64 * kb, 64 * nb, (bf16_t*)(F.ws + O_WFO + mtx * SZ_WFO1) + (size_t)(64 * nb) * 2816 + 64 * kb, 2816, scr, F.lane); continue; } r -= I_FO;
        if (r < I_LI) { const int mtx = r / 512, q = r % 512, kb = q / 32, nb = q % 32;
            tr_item(in[12] + (size_t)mtx * 1024 * 2048, 2048, 1024, 2048, 64 * kb, 64 * nb, (bf16_t*)(F.ws + O_WLI + mtx * 2 * SZ_W1M) + (size_t)(64 * nb) * 1024 + 64 * kb, 1024, scr, F.lane); continue; } r -= I_LI;
        if (r < I_LG) { const int mtx = r / 32, q = r % 32, kb = q / 8, nb = q % 8;
            tr_item(in[15] + (size_t)mtx * 256 * 512, 512, 256, 512, 64 * kb, 64 * nb, (bf16_t*)(F.ws + O_WLG) + (size_t)mtx * 512 * 256 + (size_t)ilv_row(64 * nb, 256) * 256 + 64 * kb, 256, scr, F.lane); continue; } r -= I_LG;
        if (r < I_LO) { const int mtx = r / 256, q = r % 256, kb = q / 16, nb = q % 16;
            tr_item(in[18] + (size_t)mtx * 1024 * 1024, 1024, 1024, 1024, 64 * kb, 64 * nb, (bf16_t*)(F.ws + O_WLO + mtx * SZ_W1M) + (size_t)(64 * nb) * 1024 + 64 * kb, 1024, scr, F.lane); continue; } r -= I_LO;
        if (r < I_RKV) { const int mtx = r / 256, q = r % 256, kb = q / 16, nb = q % 16;
            tr_item(in[20] + (size_t)mtx * 1024 * 1024, 1024, 1024, 1024, 64 * kb, 64 * nb, (bf16_t*)(F.ws + O_WRKV + mtx * SZ_W1M) + (size_t)(64 * nb) * 1024 + 64 * kb, 1024, scr, F.lane); continue; } r -= I_RKV;
        if (r < I_WO) { const int mtx = r / 256, q = r % 256, kb = q / 16, nb = q % 16;
            tr_item(in[21] + (size_t)mtx * 1024 * 1024, 1024, 1024, 1024, 64 * kb, 64 * nb, (bf16_t*)(F.ws + O_WO + mtx * SZ_W1M) + (size_t)(64 * nb) * 1024 + 64 * kb, 1024, scr, F.lane); continue; } r -= I_WO;
        if (r < I_L1) { const int j = r / 256, q = r % 256, w = q / 64, q2 = q % 64, kb = q2 / 4, nb = q2 % 4;
            const float* src; int Ns;
            if (w == 0) { src = in[23] + (size_t)j * 1024 * 64; Ns = 64; } else if (w == 1) { src = in[26] + (size_t)j * 1024 * 64; Ns = 64; }
            else if (w == 2) { src = in[31] + (size_t)j * 1024 * 160; Ns = 160; } else { src = in[29]; Ns = j == 1 ? 32 : 0; }
            const int ldsrc = w == 2 ? 160 : (w == 3 ? 32 : 64);
            tr_item(src, ldsrc, 1024, Ns, 64 * kb, 64 * nb, (bf16_t*)(F.ws + O_WL1 + j * SZ_WL1) + (size_t)w * 256 * 1024 + (size_t)(64 * nb) * 1024 + 64 * kb, 1024, scr, F.lane); continue; } r -= I_L1;
        if (r < I_L2) { const int j = r / 384, q = r % 384, w = q / 96, q2 = q % 96, kb = q2 / 16, nb = q2 % 16;
            const float* src; int Ks, kd0;
            if (w == 0) { src = in[24] + (size_t)j * 64 * 1024; Ks = 64; kd0 = 0; } else if (w == 1) { src = in[27] + (size_t)j * 64 * 1024; Ks = 64; kd0 = 64; }
            else if (w == 2) { src = in[32] + (size_t)j * 160 * 1024; Ks = 160; kd0 = 128; } else { src = in[30]; Ks = j == 1 ? 32 : 0; kd0 = 288; }
            tr_item(src, 1024, Ks, 1024, 64 * kb - kd0, 64 * nb, (bf16_t*)(F.ws + O_WL2 + j * SZ_WL2) + (size_t)(w * 1024 + 64 * nb) * 384 + 64 * kb, 384, scr, F.lane); continue; } r -= I_L2;
        { const int mtx = r / 2304, q = r % 2304, kb = q / 144, nb = q % 144;
            tr_item<false>(in[8] + (size_t)mtx * 1024 * NMODC, NMODC, 1024, NMODC, 64 * kb, 64 * nb, (bf16_t*)(F.ws + O_ADAT) + (size_t)(mtx * NMODC + 64 * nb) * 1024 + 64 * kb, 1024, scr, F.lane); }
    }
    const size_t gt = (size_t)F.bid * 512 + F.tid, NT = (size_t)F.G * 512;
    f32x4* xw = (f32x4*)(F.ws + O_XW);
    for (size_t i = (size_t)MP * 256 + gt; i < (size_t)MT * 256; i += NT) xw[i] = ((const f32x4*)in[1])[i - (size_t)MP * 256];
    { unsigned long long* xb = (unsigned long long*)(F.ws + O_XB); for (size_t i = gt; i < (size_t)128 * 2 * 8 * 32; i += NT) xb[i] = 0ull; }
    u32x2* cs = (u32x2*)(F.ws + O_CS);
    for (size_t i = gt; i < (size_t)256 * 256; i += NT) { const int row = (int)(i >> 8); f32x4 v = (f32x4){0.f, 0.f, 0.f, 0.f};
        if (row < 8) v = ((const f32x4*)in[6])[i]; else if (row < NCB) v = ((const f32x4*)in[7])[i - 8 * 256];
        u32x2 o; o.x = cvt_pk_bf16(fsilu(v.x), fsilu(v.y)); o.y = cvt_pk_bf16(fsilu(v.z), fsilu(v.w)); cs[i] = o; }
}

__device__ __forceinline__ void ld4(const GAS float* xrow, int lane, f32x4 (&v)[4]) {
    const GAS f32x4* xr = (const GAS f32x4*)xrow + lane;
#pragma unroll
    for (int j = 0; j < 4; ++j) v[j] = xr[64 * j];
}
__device__ __forceinline__ float rstd_of(const f32x4 (&v)[4], int lane) {
    float s = 0.f;
#pragma unroll
    for (int j = 0; j < 4; ++j) s += (v[j].x * v[j].x + v[j].y * v[j].y) + (v[j].z * v[j].z + v[j].w * v[j].w);
    return rsqrtf(wave_sum(s, lane) * (1.f / D) + 1e-6f);
}
__device__ __forceinline__ void fold4(GAS float* xrow, const GAS float* part, int nfold, int lane, f32x4 (&v)[4]) {
    for (int q = 0; q < nfold; ++q) { const GAS f32x4* pr = (const GAS f32x4*)(part + (size_t)q * (MS * D)) + lane;
#pragma unroll
        for (int j = 0; j < 4; ++j) v[j] += pr[64 * j]; }
    GAS f32x4* xr = (GAS f32x4*)xrow + lane;
#pragma unroll
    for (int j = 0; j < 4; ++j) xr[64 * j] = v[j];
}
__device__ __forceinline__ void norm_store(GAS bf16_t* HB, int row, int lane, const f32x4 (&v)[4], const f32x4 (&sh)[4], const f32x4 (&sc)[4]) {
    const float rstd = rstd_of(v, lane);
    GAS u32x2* o = (GAS u32x2*)(HB + (size_t)row * D) + lane;
#pragma unroll
    for (int j = 0; j < 4; ++j) { const f32x4 h = v[j] * rstd * (sc[j] + 1.f) + sh[j]; u32x2 w; w.x = cvt_pk_bf16(h.x, h.y); w.y = cvt_pk_bf16(h.z, h.w); o[64 * j] = w; }
}
__device__ __forceinline__ void phase_norm(Frame& F, const float* xprompt, int layer, int mi, int nfold) {
    GAS float* X = (GAS float*)(F.ws + O_XW); const GAS float* XP = (const GAS float*)xprompt; const GAS float* PART = (const GAS float*)(F.ws + O_PART); const GAS float* MOD = (const GAS float*)(F.ws + O_MOD); GAS bf16_t* HB = (GAS bf16_t*)(F.ws + O_HB);
    const int gw = F.bid * 8 + F.wave, NGW = F.G * 8;
    f32x4 sh[4], sc[4];
    for (int r0 = gw * 8; r0 < MP; r0 += NGW * 8) {
        const GAS float* mp = MOD + (size_t)(r0 >> 11) * (4 * NMODC) + layer * NMODC + mi * D; ld4(mp, F.lane, sh); ld4(mp + D, F.lane, sc);
        f32x4 v[3][4];
        ld4(XP + (size_t)r0 * D, F.lane, v[0]); ld4(XP + (size_t)(r0 + 1) * D, F.lane, v[1]);
#pragma unroll
        for (int i = 0; i < 8; ++i) { if (i + 2 < 8) ld4(XP + (size_t)(r0 + i + 2) * D, F.lane, v[(i + 2) % 3]); norm_store(HB, r0 + i, F.lane, v[i % 3], sh, sc); }
    }
    for (int row = MP + gw; row < MT; row += NGW) {
        const GAS float* mp = MOD + (size_t)cb_of(row) * (4 * NMODC) + layer * NMODC + mi * D; ld4(mp, F.lane, sh); ld4(mp + D, F.lane, sc);
        f32x4 v[4]; ld4(X + (size_t)row * D, F.lane, v);
        if (nfold > 0) fold4(X + (size_t)row * D, PART + (size_t)(row - MP) * D, nfold, F.lane, v);
        norm_store(HB, row, F.lane, v, sh, sc);
    }
}
__device__ __forceinline__ void norm_rwkv_emit(Frame& F, const GAS float* mu, const f32x4 (&sh)[4], const f32x4 (&sc)[4], int row, int j, const f32x4 (&v)[4], float rstd, f32x4 (&hp)[4], GAS float* shout_or_null) {
    GAS bf16_t* xm = (GAS bf16_t*)(F.ws + O_XM) + (size_t)row * D;
#pragma unroll
    for (int q = 0; q < 4; ++q) { const int c4 = F.lane + 64 * q;
        const f32x4 h = v[q] * rstd * (sc[q] + 1.f) + sh[q]; const f32x4 d = hp[q] - h;
#pragma unroll
        for (int jj = 0; jj < 6; ++jj) { const f32x4 m = *((const GAS f32x4*)(mu + jj * D) + c4); const f32x4 x = h + d * m;
            u32x2 w; w.x = cvt_pk_bf16(x.x, x.y); w.y = cvt_pk_bf16(x.z, x.w); *((GAS u32x2*)(xm + (size_t)jj * MT * D) + c4) = w; }
        if (shout_or_null) *((GAS f32x4*)shout_or_null + c4) = h;
        hp[q] = h; }
    GAS bf16_t* ac = (GAS bf16_t*)(F.ws + O_ACAT) + (size_t)row * 384;
    if (F.lane < 32) ((GAS unsigned*)(ac + 320))[F.lane] = 0u; else if (j == 0 && F.lane < 48) ((GAS unsigned*)(ac + 288))[F.lane - 32] = 0u;
}
__device__ __forceinline__ void phase_norm_rwkv(Frame& F, const float* const* IN, int layer, int j, int nfold) {
    GAS float* X = (GAS float*)(F.ws + O_XW); const GAS float* MOD = (const GAS float*)(F.ws + O_MOD); const GAS float* PART = (const GAS float*)(F.ws + O_PART);
    const GAS float* mu = (const GAS float*)IN[19] + (size_t)j * 6 * D;
    const int gw = F.bid * 8 + F.wave, NGW = F.G * 8;
    f32x4 v[4], hp[4], sh[4], sc[4];
    for (int r0 = gw * 8; r0 < MP; r0 += NGW * 8) {
        const int b = r0 >> 11, t0 = r0 & 2047;
        const GAS float* mp = MOD + (size_t)b * (4 * NMODC) + layer * NMODC + 3 * D; ld4(mp, F.lane, sh); ld4(mp + D, F.lane, sc);
        f32x4 w[3][4];
        ld4(X + (size_t)r0 * D, F.lane, w[0]); ld4(X + (size_t)(r0 + 1) * D, F.lane, w[1]);
        if (t0 == 0) {
#pragma unroll
            for (int q = 0; q < 4; ++q) hp[q] = (f32x4){0.f, 0.f, 0.f, 0.f}; }
        else { f32x4 p[4]; ld4(X + (size_t)(r0 - 1) * D, F.lane, p); const float rp = rstd_of(p, F.lane);
#pragma unroll
            for (int q = 0; q < 4; ++q) hp[q] = p[q] * rp * (sc[q] + 1.f) + sh[q]; }
#pragma unroll
        for (int i = 0; i < 8; ++i) { if (i + 2 < 8) ld4(X + (size_t)(r0 + i + 2) * D, F.lane, w[(i + 2) % 3]);
            const float rstd = rstd_of(w[i % 3], F.lane);
            norm_rwkv_emit(F, mu, sh, sc, r0 + i, j, w[i % 3], rstd, hp, (i == 7 && t0 == 2040) ? (GAS float*)F.out + OUT_P_SHIFT + (size_t)(j * 8 + b) * D : nullptr); }
    }
    for (int b = gw; b < 128; b += NGW) {
        ld4((const GAS float*)IN[4] + (size_t)(j * 128 + b) * D, F.lane, hp);
        const GAS float* mp = MOD + (size_t)(8 + b) * (4 * NMODC) + layer * NMODC + 3 * D; ld4(mp, F.lane, sh); ld4(mp + D, F.lane, sc);
        for (int t = 0; t < 8; ++t) { const int row = MP + b * 8 + t;
            ld4(X + (size_t)row * D, F.lane, v);
            if (nfold > 0) fold4(X + (size_t)row * D, PART + (size_t)(row - MP) * D, nfold, F.lane, v);
            const float rstd = rstd_of(v, F.lane);
            norm_rwkv_emit(F, mu, sh, sc, row, j, v, rstd, hp, t == 7 ? (GAS float*)F.out + OUT_S_SHIFT + (size_t)(j * 128 + b) * D : nullptr); }
    }
}
__device__ __forceinline__ void final_store(GAS float* OUT, int row, int lane, const f32x4 (&v)[4], const f32x4 (&gn)[4]) {
    const float rstd = rstd_of(v, lane);
    GAS f32x4* o = (GAS f32x4*)(OUT + OUT_Y + (size_t)row * D) + lane;
#pragma unroll
    for (int j = 0; j < 4; ++j) __builtin_nontemporal_store(v[j] * rstd * gn[j], o + 64 * j);
}
__device__ __forceinline__ void phase_final(Frame& F, const float* const* IN, int nfold) {
    GAS float* X = (GAS float*)(F.ws + O_XW); const GAS float* PART = (const GAS float*)(F.ws + O_PART); GAS float* OUT = (GAS float*)F.out;
    const int gw = F.bid * 8 + F.wave, NGW = F.G * 8;
    f32x4 gn[4]; ld4((const GAS float*)IN[38], F.lane, gn);
    for (int r0 = gw * 8; r0 < MP; r0 += NGW * 8) {
        f32x4 v[3][4];
        ld4(X + (size_t)r0 * D, F.lane, v[0]); ld4(X + (size_t)(r0 + 1) * D, F.lane, v[1]);
#pragma unroll
        for (int i = 0; i < 8; ++i) { if (i + 2 < 8) ld4(X + (size_t)(r0 + i + 2) * D, F.lane, v[(i + 2) % 3]); final_store(OUT, r0 + i, F.lane, v[i % 3], gn); }
    }
    for (int row = MP + gw; row < MT; row += NGW) {
        f32x4 v[4]; ld4(X + (size_t)row * D, F.lane, v);
        if (nfold > 0) fold4(X + (size_t)row * D, PART + (size_t)(row - MP) * D, nfold, F.lane, v);
        final_store(OUT, row, F.lane, v, gn);
    }
}

__device__ __forceinline__ void phase_conv(Frame& F, const float* const* IN, int j) {
    const GAS float* REC = (const GAS float*)(F.ws + O_REC); GAS bf16_t* XC = (GAS bf16_t*)(F.ws + O_XC);
    const GAS float* cw = (const GAS float*)IN[13] + (size_t)j * 4 * D; const GAS float* cbias = (const GAS float*)IN[14] + (size_t)j * D;
    const int gt = F.bid * 512 + F.tid, NT = F.G * 512;
    for (int i = gt; i < (MT / 34) * 256; i += NT) {
        const int c4 = i & 255, ra = (i >> 8) * 34;
        const f32x4 k0 = *((const GAS f32x4*)cw + c4), k1 = *((const GAS f32x4*)(cw + D) + c4), k2 = *((const GAS f32x4*)(cw + 2 * D) + c4), k3 = *((const GAS f32x4*)(cw + 3 * D) + c4), kb = *((const GAS f32x4*)cbias + c4);
        f32x4 w0, w1, w2;
        { const int row = ra; int t; const GAS float* buf = nullptr;
          if (row < MP) t = row & 2047; else { t = (row - MP) & 7; buf = (const GAS float*)IN[3] + (size_t)(j * 128 + ((row - MP) >> 3)) * 3 * D; }
          const f32x4 z = (f32x4){0.f, 0.f, 0.f, 0.f};
          w0 = t >= 3 ? *((const GAS f32x4*)(REC + (size_t)(row - 3) * D) + c4) : (buf ? *((const GAS f32x4*)(buf + (size_t)t * D) + c4) : z);
          w1 = t >= 2 ? *((const GAS f32x4*)(REC + (size_t)(row - 2) * D) + c4) : (buf ? *((const GAS f32x4*)(buf + (size_t)(t + 1) * D) + c4) : z);
          w2 = t >= 1 ? *((const GAS f32x4*)(REC + (size_t)(row - 1) * D) + c4) : (buf ? *((const GAS f32x4*)(buf + (size_t)(t + 2) * D) + c4) : z); }
        for (int bb = 0; bb < 2; ++bb) {
            f32x4 cv[17];
#pragma unroll
            for (int r = 0; r < 17; ++r) cv[r] = *((const GAS f32x4*)(REC + (size_t)(ra + bb * 17 + r) * D) + c4);
#pragma unroll
            for (int r = 0; r < 17; ++r) {
                const int row = ra + bb * 17 + r; int b, t, T; GAS float* cout;
                if (row < MP) { b = row >> 11; t = row & 2047; T = 2048; cout = (GAS float*)F.out + OUT_P_CONV + (size_t)(j * 8 + b) * 3 * D;
                    if (t == 0) { w0 = w1 = w2 = (f32x4){0.f, 0.f, 0.f, 0.f}; } }
                else { b = (row - MP) >> 3; t = (row - MP) & 7; T = 8; cout = (GAS float*)F.out + OUT_S_CONV + (size_t)(j * 128 + b) * 3 * D;
                    if (t == 0) { const GAS float* buf = (const GAS float*)IN[3] + (size_t)(j * 128 + b) * 3 * D; w0 = *((const GAS f32x4*)buf + c4); w1 = *((const GAS f32x4*)(buf + D) + c4); w2 = *((const GAS f32x4*)(buf + 2 * D) + c4); } }
                const f32x4 cur = cv[r];
                const f32x4 y = kb + w0 * k0 + w1 * k1 + w2 * k2 + cur * k3;
                u32x2 w; w.x = cvt_pk_bf16(y.x, y.y); w.y = cvt_pk_bf16(y.z, y.w); *((GAS u32x2*)(XC + (size_t)row * D) + c4) = w;
                if (t >= T - 3) *((GAS f32x4*)(cout + (size_t)(t - (T - 3)) * D) + c4) = cur;
                w0 = w1; w1 = w2; w2 = cur;
            }
        }
    }
}
__device__ __forceinline__ void phase_scan_a(Frame& F) {
    const GAS float* AA = (const GAS float*)(F.ws + O_AA); const GAS float* UU = (const GAS float*)(F.ws + O_UU); GAS f32x2* AGG = (GAS f32x2*)(F.ws + O_AGG);
    const int gt = F.bid * 512 + F.tid, NT = F.G * 512;
    for (int i = gt; i < 8 * 16 * 1024; i += NT) { const int ch = i & 1023, seg = (i >> 10) & 15, b = i >> 14;
        const size_t base = ((size_t)b * 2048 + seg * 128) * D + ch; float P = 1.f, h = 0.f;
#pragma unroll 16
        for (int t = 0; t < 128; ++t) { const float a = AA[base + (size_t)t * D], u = UU[base + (size_t)t * D]; P *= a; h = a * h + u; }
        AGG[i] = (f32x2){P, h}; }
}
__device__ __forceinline__ void phase_scan_b(Frame& F, const float* const* IN, int j) {
    const GAS float* AA = (const GAS float*)(F.ws + O_AA); const GAS float* UU = (const GAS float*)(F.ws + O_UU); const GAS f32x2* AGG = (const GAS f32x2*)(F.ws + O_AGG);
    const GAS bf16_t* GG = (const GAS bf16_t*)(F.ws + O_GG); GAS bf16_t* HB = (GAS bf16_t*)(F.ws + O_HB); GAS float* OUT = (GAS float*)F.out;
    const int gt = F.bid * 512 + F.tid, NT = F.G * 512;
    for (int i = gt; i < 2 * 8 * 16 * 1024; i += NT) {
        if (i < 8 * 16 * 1024) { const int ch = i & 1023, seg = (i >> 10) & 15, b = i >> 14;
            float h = 0.f;
#pragma unroll
            for (int q = 0; q < 15; ++q) { const f32x2 g = AGG[(b * 16 + (q < seg ? q : 0)) * 1024 + ch]; h = q < seg ? g.x * h + g.y : h; }
            const size_t base = ((size_t)b * 2048 + seg * 128) * D + ch;
#pragma unroll 16
            for (int t = 0; t < 128; ++t) { const size_t o = base + (size_t)t * D; h = AA[o] * h + UU[o]; HB[o] = (bf16_t)(cvt_pk_bf16(h * bf_lo((unsigned)GG[o]), 0.f) & 0xffffu); }
            if (seg == 15) OUT[OUT_P_H + (size_t)(j * 8 + b) * D + ch] = h;
        } else { const int q = i - 8 * 16 * 1024, ch = q & 1023, b = q >> 10;
            float h = ((const GAS float*)IN[2])[(size_t)(j * 128 + b) * D + ch];
            const size_t base = ((size_t)MP + b * 8) * D + ch;
#pragma unroll
            for (int t = 0; t < 8; ++t) { const size_t o = base + (size_t)t * D; h = AA[o] * h + UU[o]; HB[o] = (bf16_t)(cvt_pk_bf16(h * bf_lo((unsigned)GG[o]), 0.f) & 0xffffu); }
            OUT[OUT_S_H + (size_t)(j * 128 + b) * D + ch] = h; }
    }
}

__device__ __forceinline__ void wkv_full(Frame& F, const float* const* IN, int j, int it, int step, int itend) {
    const GAS bf16_t* Rb = (const GAS bf16_t*)(F.ws + O_R); const GAS bf16_t* Kb = (const GAS bf16_t*)(F.ws + O_K);
    const GAS float* Vb = (const GAS float*)(F.ws + O_V); const GAS float* Wb = (const GAS float*)(F.ws + O_WD); const GAS float* Ab = (const GAS float*)(F.ws + O_AS); const GAS float* Gb = (const GAS float*)(F.ws + O_GS);
    GAS bf16_t* HB = (GAS bf16_t*)(F.ws + O_HB);
    const GAS float* k_k = (const GAS float*)IN[33] + (size_t)j * D; const GAS float* k_a = (const GAS float*)IN[34] + (size_t)j * D; const GAS float* r_k = (const GAS float*)IN[35] + (size_t)j * D;
    const GAS float* ln_w = (const GAS float*)IN[36] + (size_t)j * D; const GAS float* ln_b = (const GAS float*)IN[37] + (size_t)j * D;
    LAS float* sr = (LAS float*)F.lds; LAS float* sw = sr + 1024; LAS float* sk = sw + 1024; LAS float* sa = sk + 1024; LAS float* sb = sa + 1024; LAS float* sv = sb + 1024; LAS float* sy = sv + 1024;
    const int tt = F.tid >> 5, kp = F.tid & 31;
    const int srow = (F.wave & 3) * 16 + 2 * (F.lane >> 3), seg = F.lane & 7;
    for (; it < itend; it += step) {
        int b, h, T, row0; const GAS float* S0 = nullptr; GAS float* Sout;
        if (it < 128) { b = it >> 4; h = it & 15; T = 2048; row0 = b * 2048; Sout = (GAS float*)F.out + OUT_P_WKV + ((size_t)(j * 8 + b) * 16 + h) * 4096; }
        else { const int si = it - 128; b = si >> 4; h = si & 15; T = 8; row0 = MP + b * 8; S0 = (const GAS float*)IN[5] + ((size_t)(j * 128 + b) * 16 + h) * 4096; Sout = (GAS float*)F.out + OUT_S_WKV + ((size_t)(j * 128 + b) * 16 + h) * 4096; }
        const int ct = T < 16 ? T : 16, nch = T / ct;
        f32x2 Sa[4], Sb[4];
        if (S0) { const f32x4 s0 = __builtin_nontemporal_load((const GAS f32x4*)(S0 + srow * 64 + seg * 8)), s1 = __builtin_nontemporal_load((const GAS f32x4*)(S0 + srow * 64 + seg * 8 + 4)), s2 = __builtin_nontemporal_load((const GAS f32x4*)(S0 + srow * 64 + 64 + seg * 8)), s3 = __builtin_nontemporal_load((const GAS f32x4*)(S0 + srow * 64 + 64 + seg * 8 + 4));
            Sa[0] = s0.xy; Sa[1] = s0.zw; Sa[2] = s1.xy; Sa[3] = s1.zw; Sb[0] = s2.xy; Sb[1] = s2.zw; Sb[2] = s3.xy; Sb[3] = s3.zw; }
        else {
#pragma unroll
            for (int i = 0; i < 4; ++i) { Sa[i] = (f32x2){0.f, 0.f}; Sb[i] = (f32x2){0.f, 0.f}; } }
        const int col = h * 64 + 2 * kp;
        const f32x2 ckk = *(const GAS f32x2*)(k_k + col), cka = *(const GAS f32x2*)(k_a + col), crk = *(const GAS f32x2*)(r_k + col), clw = *(const GAS f32x2*)(ln_w + col), clb = *(const GAS f32x2*)(ln_b + col);
        const bool act = tt < ct;
        unsigned nr = 0, nk = 0; f32x2 nv = {0.f, 0.f}, nw = {0.f, 0.f}, na = {0.f, 0.f}, ng = {0.f, 0.f};
        if (act) { const size_t o = (size_t)(row0 + tt) * D + col; nr = *(const GAS unsigned*)(Rb + o); nk = *(const GAS unsigned*)(Kb + o); nv = *(const GAS f32x2*)(Vb + o); nw = *(const GAS f32x2*)(Wb + o); na = *(const GAS f32x2*)(Ab + o); ng = *(const GAS f32x2*)(Gb + o); }
        for (int c = 0; c < nch; ++c) {
            const f32x2 r2 = {bf_lo(nr), bf_hi(nr)}, k2 = {bf_lo(nk), bf_hi(nk)}, v2 = nv, w2 = nw, a2 = na, g2 = ng;
            float rk = 0.f;
            if (act) {
                f32x2 kk = k2 * ckk; const float ss = half_sum(kk.x * kk.x + kk.y * kk.y, F.lane);
                kk = kk * frcp(fmaxf(sqrtf(ss), 1e-12f));
                const f32x2 kn = k2 * ((a2 - 1.f) * cka + 1.f);
                rk = half_sum(r2.x * kn.x * crk.x + r2.y * kn.y * crk.y, F.lane);
                const int o = tt * 64 + 2 * kp;
                *(LAS f32x2*)(sr + o) = r2; *(LAS f32x2*)(sw + o) = w2; *(LAS f32x2*)(sk + o) = kn; *(LAS f32x2*)(sa + o) = -kk; *(LAS f32x2*)(sb + o) = kk * a2; *(LAS f32x2*)(sv + o) = v2;
            }
            if (act && c + 1 < nch) { const size_t o = (size_t)(row0 + (c + 1) * ct + tt) * D + col; nr = *(const GAS unsigned*)(Rb + o); nk = *(const GAS unsigned*)(Kb + o); nv = *(const GAS f32x2*)(Vb + o); nw = *(const GAS f32x2*)(Wb + o); na = *(const GAS f32x2*)(Ab + o); ng = *(const GAS f32x2*)(Gb + o); }
            { asm volatile("s_waitcnt lgkmcnt(0)" ::: "memory"); __builtin_amdgcn_s_barrier(); asm volatile("" ::: "memory"); }
            if (F.wave < 4) {
                f32x4 Pa0, Pa1, Pw0, Pw1, Pb0, Pb1, Pk0, Pk1, Pr0, Pr1; f32x2 Pvv;
                f32x4 Qa0, Qa1, Qw0, Qw1, Qb0, Qb1, Qk0, Qk1, Qr0, Qr1; f32x2 Qvv;
#define WKV_LD(P, t_) do { const int _o = (t_) * 64 + seg * 8; P##a0 = *(const LAS f32x4*)(sa + _o); P##a1 = *(const LAS f32x4*)(sa + _o + 4); P##w0 = *(const LAS f32x4*)(sw + _o); P##w1 = *(const LAS f32x4*)(sw + _o + 4); \
                    P##b0 = *(const LAS f32x4*)(sb + _o); P##b1 = *(const LAS f32x4*)(sb + _o + 4); P##k0 = *(const LAS f32x4*)(sk + _o); P##k1 = *(const LAS f32x4*)(sk + _o + 4); \
                    P##r0 = *(const LAS f32x4*)(sr + _o); P##r1 = *(const LAS f32x4*)(sr + _o + 4); P##vv = *(const LAS f32x2*)(sv + (t_) * 64 + srow); } while (0)
#define WKV_ROW(S, P, vsc, yout) do { f32x2 q = S[0] * P##a0.xy; q = S[1] * P##a0.zw + q; f32x2 q2 = S[2] * P##a1.xy; q2 = S[3] * P##a1.zw + q2; q += q2; \
                    const float p = sum8(q.x + q.y); const f32x2 pp = {p, p}, v2s = {vsc, vsc}; \
                    S[0] = S[0] * P##w0.xy + pp * P##b0.xy + v2s * P##k0.xy; S[1] = S[1] * P##w0.zw + pp * P##b0.zw + v2s * P##k0.zw; \
                    S[2] = S[2] * P##w1.xy + pp * P##b1.xy + v2s * P##k1.xy; S[3] = S[3] * P##w1.zw + pp * P##b1.zw + v2s * P##k1.zw; \
                    f32x2 y2 = S[0] * P##r0.xy; y2 = S[1] * P##r0.zw + y2; f32x2 y3 = S[2] * P##r1.xy; y3 = S[3] * P##r1.zw + y3; y2 += y3; \
                    yout = sum8(y2.x + y2.y); } while (0)
#define WKV_STEP(P, t_) do { float ya, yb; WKV_ROW(Sa, P, P##vv.x, ya); WKV_ROW(Sb, P, P##vv.y, yb); *(LAS f32x2*)(sy + (t_) * 64 + srow) = (f32x2){ya, yb}; } while (0)
                WKV_LD(P, 0);
                for (int t = 0; t < ct; t += 2) {
                    WKV_LD(Q, t + 1);
                    WKV_STEP(P, t);
                    if (t + 2 < ct) WKV_LD(P, t + 2);
                    WKV_STEP(Q, t + 1);
                }
#undef WKV_LD
#undef WKV_ROW
#undef WKV_STEP
            }
            { asm volatile("s_waitcnt lgkmcnt(0)" ::: "memory"); __builtin_amdgcn_s_barrier(); asm volatile("" ::: "memory"); }
            if (act) {
                const f32x2 y2 = *(const LAS f32x2*)(sy + tt * 64 + 2 * kp);
                const float mean = half_sum(y2.x + y2.y, F.lane) * (1.f / 64.f);
                const f32x2 d = y2 - mean; const float var = half_sum(d.x * d.x + d.y * d.y, F.lane) * (1.f / 64.f);
                const float rs = rsqrtf(var + 64e-5f);
                const f32x2 o2 = (d * rs * clw + clb + v2 * rk) * g2;
                *(GAS unsigned*)(HB + (size_t)(row0 + c * ct + tt) * D + col) = cvt_pk_bf16(o2.x, o2.y);
            }
        }
        if (F.wave < 4) { __builtin_nontemporal_store((f32x4){Sa[0].x, Sa[0].y, Sa[1].x, Sa[1].y}, (GAS f32x4*)(Sout + srow * 64 + seg * 8)); __builtin_nontemporal_store((f32x4){Sa[2].x, Sa[2].y, Sa[3].x, Sa[3].y}, (GAS f32x4*)(Sout + srow * 64 + seg * 8 + 4));
            __builtin_nontemporal_store((f32x4){Sb[0].x, Sb[0].y, Sb[1].x, Sb[1].y}, (GAS f32x4*)(Sout + srow * 64 + 64 + seg * 8)); __builtin_nontemporal_store((f32x4){Sb[2].x, Sb[2].y, Sb[3].x, Sb[3].y}, (GAS f32x4*)(Sout + srow * 64 + 64 + seg * 8 + 4)); }
        { asm volatile("s_waitcnt lgkmcnt(0)" ::: "memory"); __builtin_amdgcn_s_barrier(); asm volatile("" ::: "memory"); }
    }
}


__device__ __forceinline__ void wkv_half(Frame& F, const float* const* IN, int j) {
    const GAS bf16_t* Rb = (const GAS bf16_t*)(F.ws + O_R); const GAS bf16_t* Kb = (const GAS bf16_t*)(F.ws + O_K);
    const GAS float* Vb = (const GAS float*)(F.ws + O_V); const GAS float* Wb = (const GAS float*)(F.ws + O_WD); const GAS float* Ab = (const GAS float*)(F.ws + O_AS); const GAS float* Gb = (const GAS float*)(F.ws + O_GS);
    GAS bf16_t* HB = (GAS bf16_t*)(F.ws + O_HB);
    const GAS float* k_k = (const GAS float*)IN[33] + (size_t)j * D; const GAS float* k_a = (const GAS float*)IN[34] + (size_t)j * D; const GAS float* r_k = (const GAS float*)IN[35] + (size_t)j * D;
    const GAS float* ln_w = (const GAS float*)IN[36] + (size_t)j * D; const GAS float* ln_b = (const GAS float*)IN[37] + (size_t)j * D;
    LAS float* sr = (LAS float*)F.lds;
    LAS float* sw = sr + 2048; LAS float* sk = sw + 2048; LAS float* sa = sk + 2048; LAS float* sb = sa + 2048;
    LAS float* sv = sb + 2048;
    LAS float* sg = sv + 8 * 1024;
    LAS float* sy = sg + 8 * 1024;
    LAS float* srk = sy + 8 * 512;
    LAS float* sst = srk + 8 * 16;
    const int item = ((F.bid >> 4) << 3) | (F.bid & 7), half = (F.bid >> 3) & 1, b = item >> 4, h = item & 15, row0 = b * 2048, rbase = 32 * half;
    GAS unsigned long long* xmine = (GAS unsigned long long*)(F.ws + O_XB) + (size_t)((item * 2 + half) * 8) * 32;
    GAS unsigned long long* xpart = (GAS unsigned long long*)(F.ws + O_XB) + (size_t)((item * 2 + (half ^ 1)) * 8) * 32;
    const unsigned tagbase = (unsigned)(j + 1) << 16;
#define WKV_BAR() do { asm volatile("s_waitcnt lgkmcnt(0)" ::: "memory"); __builtin_amdgcn_s_barrier(); asm volatile("" ::: "memory"); } while (0)
    if (F.wave < 4) {
        const int srow = rbase + F.wave * 8 + (F.lane >> 3), seg = F.lane & 7;
        f32x2 S[4];
#pragma unroll
        for (int i = 0; i < 4; ++i) S[i] = (f32x2){0.f, 0.f};
        WKV_BAR();
        __builtin_amdgcn_s_setprio(3);
        for (int c = 0; c < 131; ++c) {
            if (c < 128) {
                const int bi = c & 7, vo = (c & 1) * 1024;
                f32x4 Pa0, Pa1, Pw0, Pw1, Pb0, Pb1, Pk0, Pk1, Pr0, Pr1; float Pvv;
                f32x4 Qa0, Qa1, Qw0, Qw1, Qb0, Qb1, Qk0, Qk1, Qr0, Qr1; float Qvv;
#define WKV_LD(P, t_) do { const int _o = vo + (t_) * 64 + seg * 8; P##a0 = *(const LAS f32x4*)(sa + _o); P##a1 = *(const LAS f32x4*)(sa + _o + 4); P##w0 = *(const LAS f32x4*)(sw + _o); P##w1 = *(const LAS f32x4*)(sw + _o + 4); \
                P##b0 = *(const LAS f32x4*)(sb + _o); P##b1 = *(const LAS f32x4*)(sb + _o + 4); P##k0 = *(const LAS f32x4*)(sk + _o); P##k1 = *(const LAS f32x4*)(sk + _o + 4); \
                P##r0 = *(const LAS f32x4*)(sr + _o); P##r1 = *(const LAS f32x4*)(sr + _o + 4); P##vv = sv[bi * 1024 + (t_) * 64 + srow]; } while (0)
#define WKV_STEP(P, N, t_, HASN) do { const f32x2 pp = {pa, pa}, v2s = {P##vv, P##vv}; \
                S[0] = S[0] * P##w0.xy + pp * P##b0.xy + v2s * P##k0.xy; S[1] = S[1] * P##w0.zw + pp * P##b0.zw + v2s * P##k0.zw; \
                S[2] = S[2] * P##w1.xy + pp * P##b1.xy + v2s * P##k1.xy; S[3] = S[3] * P##w1.zw + pp * P##b1.zw + v2s * P##k1.zw; \
                f32x2 y2 = S[0] * P##r0.xy; y2 = S[1] * P##r0.zw + y2; f32x2 y3 = S[2] * P##r1.xy; y3 = S[3] * P##r1.zw + y3; y2 += y3; \
                float ys = y2.x + y2.y; \
                if (HASN) { f32x2 q = S[0] * N##a0.xy; q = S[1] * N##a0.zw + q; f32x2 q2 = S[2] * N##a1.xy; q2 = S[3] * N##a1.zw + q2; q += q2; float qs = q.x + q.y; \
                    ys += dpp_f<0xB1>(ys); qs += dpp_f<0xB1>(qs); ys += dpp_f<0x4E>(ys); qs += dpp_f<0x4E>(qs); ys += dpp_f<0x141>(ys); qs += dpp_f<0x141>(qs); pa = qs; } \
                else ys = sum8(ys); \
                sy[bi * 512 + (t_) * 32 + (srow - rbase)] = ys; } while (0)
                WKV_LD(P, 0);
                float pa; { f32x2 q = S[0] * Pa0.xy; q = S[1] * Pa0.zw + q; f32x2 q2 = S[2] * Pa1.xy; q2 = S[3] * Pa1.zw + q2; q += q2; pa = sum8(q.x + q.y); }
                for (int t = 0; t < 16; t += 2) {
                    WKV_LD(Q, t + 1);
                    WKV_STEP(P, Q, t, true);
                    if (t + 2 < 16) WKV_LD(P, t + 2);
                    WKV_STEP(Q, P, t + 1, t + 2 < 16);
                }
#undef WKV_LD
#undef WKV_STEP
            }
            WKV_BAR();
        }
        __builtin_amdgcn_s_setprio(0);
        GAS float* Sout = (GAS float*)F.out + OUT_P_WKV + ((size_t)(j * 8 + b) * 16 + h) * 4096 + (size_t)srow * 64 + seg * 8;
        *(GAS f32x4*)Sout = (f32x4){S[0].x, S[0].y, S[1].x, S[1].y}; *(GAS f32x4*)(Sout + 4) = (f32x4){S[2].x, S[2].y, S[3].x, S[3].y};
    } else {
        const int lid = F.tid - 256, tt = lid >> 4, kq = lid & 15;
        const int col = h * 64 + 4 * kq, pc = h * 64 + rbase + 2 * kq;
        const f32x4 ckk = *(const GAS f32x4*)(k_k + col), cka = *(const GAS f32x4*)(k_a + col), crk = *(const GAS f32x4*)(r_k + col);
        const f32x2 plw = *(const GAS f32x2*)(ln_w + pc), plb = *(const GAS f32x2*)(ln_b + pc);
        u32x2 nr, nk; f32x4 nv, nw, na, ng;
#define WKV_GLD(cc) do { const size_t _o = (size_t)(row0 + (cc) * 16 + tt) * D + col; nr = *(const GAS u32x2*)(Rb + _o); nk = *(const GAS u32x2*)(Kb + _o); nv = *(const GAS f32x4*)(Vb + _o); nw = *(const GAS f32x4*)(Wb + _o); na = *(const GAS f32x4*)(Ab + _o); ng = *(const GAS f32x4*)(Gb + _o); } while (0)
#define WKV_PREP(cc) do { const int _bi = (cc) & 7, _vo = ((cc) & 1) * 1024; \
            const f32x4 r4 = {bf_lo(nr.x), bf_hi(nr.x), bf_lo(nr.y), bf_hi(nr.y)}, k4 = {bf_lo(nk.x), bf_hi(nk.x), bf_lo(nk.y), bf_hi(nk.y)}; \
            f32x4 kk = k4 * ckk; const float ss = row16_sum((kk.x * kk.x + kk.y * kk.y) + (kk.z * kk.z + kk.w * kk.w)); \
            kk = kk * frcp(fmaxf(sqrtf(ss), 1e-12f)); \
            const f32x4 kn = k4 * ((na - 1.f) * cka + 1.f); \
            const float rk = row16_sum((r4.x * kn.x * crk.x + r4.y * kn.y * crk.y) + (r4.z * kn.z * crk.z + r4.w * kn.w * crk.w)); \
            const int _o = tt * 64 + 4 * kq; \
            *(LAS f32x4*)(sr + _vo + _o) = r4; *(LAS f32x4*)(sw + _vo + _o) = nw; *(LAS f32x4*)(sk + _vo + _o) = kn; *(LAS f32x4*)(sa + _vo + _o) = -kk; *(LAS f32x4*)(sb + _vo + _o) = kk * na; \
            *(LAS f32x4*)(sv + _bi * 1024 + _o) = nv; *(LAS f32x4*)(sg + _bi * 1024 + _o) = ng; if (kq == 0) srk[_bi * 16 + tt] = rk; } while (0)
#define WKV_XLD(cc, g1_, g2_) do { g1_ = __hip_atomic_load(xpart + ((cc) & 7) * 32 + tt * 2, __ATOMIC_RELAXED, __HIP_MEMORY_SCOPE_AGENT); g2_ = __hip_atomic_load(xpart + ((cc) & 7) * 32 + tt * 2 + 1, __ATOMIC_RELAXED, __HIP_MEMORY_SCOPE_AGENT); } while (0)
        WKV_GLD(0); WKV_PREP(0); WKV_GLD(1);
        WKV_BAR();
        for (int c = 0; c < 131; ++c) {
            unsigned long long eg1 = 0ull, eg2 = 0ull;
            if (c >= 3) WKV_XLD(c - 3, eg1, eg2);
            if (c >= 1 && c <= 128) {
                const int cc = c - 1, bi = cc & 7;
                const f32x2 y = *(const LAS f32x2*)(sy + bi * 512 + tt * 32 + 2 * kq);
                const float s1 = row16_sum(y.x + y.y), s2 = row16_sum(y.x * y.x + y.y * y.y);
                if (kq == 0) { sst[bi * 32 + tt * 2] = s1; sst[bi * 32 + tt * 2 + 1] = s2;
                    const unsigned long long tg = (unsigned long long)(tagbase | (unsigned)(cc + 1)) << 32;
                    __hip_atomic_store(xmine + (cc & 7) * 32 + tt * 2, tg | (unsigned long long)__float_as_uint(s1), __ATOMIC_RELAXED, __HIP_MEMORY_SCOPE_AGENT);
                    __hip_atomic_store(xmine + (cc & 7) * 32 + tt * 2 + 1, tg | (unsigned long long)__float_as_uint(s2), __ATOMIC_RELAXED, __HIP_MEMORY_SCOPE_AGENT); }
            }
            if (c + 1 < 128) { WKV_PREP(c + 1); if (c + 2 < 128) WKV_GLD(c + 2); }
            if (c >= 3) {
                const int cc = c - 3, bi = cc & 7;
                const f32x2 y = *(const LAS f32x2*)(sy + bi * 512 + tt * 32 + 2 * kq); const float s1 = sst[bi * 32 + tt * 2], s2 = sst[bi * 32 + tt * 2 + 1];
                const unsigned tag = tagbase | (unsigned)(cc + 1);
                for (int sp = 0; sp < (1 << 20); ++sp) { if ((unsigned)(eg1 >> 32) == tag && (unsigned)(eg2 >> 32) == tag) break; __builtin_amdgcn_s_sleep(1); WKV_XLD(cc, eg1, eg2); }
                const float mean = (s1 + __uint_as_float((unsigned)eg1)) * (1.f / 64.f); const float var = fmaxf((s2 + __uint_as_float((unsigned)eg2)) * (1.f / 64.f) - mean * mean, 0.f);
                const float rs = rsqrtf(var + 64e-5f);
                const f32x2 v2 = *(const LAS f32x2*)(sv + bi * 1024 + tt * 64 + rbase + 2 * kq), g2 = *(const LAS f32x2*)(sg + bi * 1024 + tt * 64 + rbase + 2 * kq); const float rk = srk[bi * 16 + tt];
                const f32x2 o2 = ((y - mean) * rs * plw + plb + v2 * rk) * g2;
                *(GAS unsigned*)(HB + (size_t)(row0 + cc * 16 + tt) * D + pc) = cvt_pk_bf16(o2.x, o2.y);
            }
            WKV_BAR();
        }
#undef WKV_GLD
#undef WKV_PREP
#undef WKV_XLD
    }
    WKV_BAR();
#undef WKV_BAR
}
__device__ __forceinline__ void phase_wkv(Frame& F, const float* const* IN, int j) {
    if (F.G == 256) { wkv_half(F, IN, j); wkv_full(F, IN, j, 128 + F.bid, 256, 128 + 2048); }
    else wkv_full(F, IN, j, F.bid, F.G, 128 + 2048);
}

constexpr int NPH = 2 + 13 + 11 + 13 + 11 + 1;
__global__ void __launch_bounds__(512, 2) mk_fwd(Args args) {
    extern __shared__ __attribute__((aligned(16))) unsigned char shm[];
    cg::grid_group grid = cg::this_grid();
    Frame F; F.lds = (LAS unsigned char*)shm; F.ws = args.ws; F.out = args.out;
    const int wave0 = __builtin_amdgcn_readfirstlane(threadIdx.x >> 6);
    F.tid = threadIdx.x; F.lane = threadIdx.x & 63; F.wave = wave0; F.G = gridDim.x; F.bid = blockIdx.x;
    const int lo = args.lo, hi = args.hi;
    if (threadIdx.x == 0) { const float** tab = (const float**)(args.ws + O_TAB);
#pragma unroll
        for (int i = 0; i < 39; ++i) tab[i] = args.in[i]; }
    if (threadIdx.x < 2) ((volatile LAS unsigned*)(F.lds + LDS_BYTES - 64))[threadIdx.x] = 0u;
    __threadfence(); __syncthreads();
    XcdBarrier bar = xcd_barrier_post((unsigned*)(args.ws + O_BAR), (volatile LAS unsigned*)(F.lds + LDS_BYTES - 64));
    int ph = 0;
#define RUNG(grp, ...) do { if (ph >= lo && ph < hi) { { int _wv = wave0; asm volatile("" : "+s"(_wv)); int _l; asm volatile("v_mbcnt_lo_u32_b32 %0, -1, 0\n\tv_mbcnt_hi_u32_b32 %0, -1, %0" : "=v"(_l)); F.wave = _wv; F.lane = _l; F.tid = _wv * 64 + _l; int _b = blockIdx.x; asm volatile("" : "+s"(_b)); F.bid = _b; unsigned char* _w = args.ws; asm volatile("" : "+s"(_w)); F.ws = _w; float* _o = args.out; asm volatile("" : "+s"(_o)); F.out = _o; } for (int rep = 0; rep < ((PROBE) == (grp) ? 2 : 1); ++rep) { if (rep) xcd_barrier(bar); __VA_ARGS__; } if (ph + 1 < hi) { if (ph == 0) grid.sync(); else xcd_barrier(bar); } } ++ph; } while (0)
#define TABP ((const float* const*)(F.ws + O_TAB))
#define WSC ((const char*)F.ws)
#define MODP ((float*)(F.ws + O_MOD))
#define XWP ((float*)(F.ws + O_XW))
    RUNG(1, phase_prep(F, TABP));
    RUNG(2, { Sched1 S{WSC + O_CS, WSC + O_ADAT, 1, 144, (size_t)256 * 1024 * 2, (size_t)256 * 1024 * 2, 16, F.G, F.bid}; EpiMod E{MODP, TABP[9]}; gemm_phase(F.lds, F.tid, 1024, 1024, 1024, S, E); });
#if PROBE == 14
    for (int q = 0; q < 20; ++q) xcd_barrier(bar);
#endif
    for (int layer = 0; layer < 4; ++layer) {
        const int j = layer >> 1;
        for (int s = 0; s < 3; ++s) {
            if (s != 1) {
                const int f = s >> 1, mi = s == 0 ? 0 : 6;
                RUNG(3, phase_norm(F, (layer == 0 && s == 0) ? TABP[0] : (const float*)(F.ws + O_XW), layer, mi, rep ? 0 : (s == 0 ? (layer == 0 ? 0 : 5) : 4)));
                RUNG(4, { Sched1 S{WSC + O_HB, WSC + O_WFI + (size_t)(layer * 2 + f) * SZ_WFI1, MT / 256, 22, (size_t)256 * 1024 * 2, (size_t)256 * 1024 * 2, 16, F.G, F.bid}; EpiSwiglu E{(bf16_t*)(F.ws + O_ACT)}; gemm_phase<true>(F.lds, F.tid, 1024, 1024, 1024, S, E); });
                RUNG(5, { SchedResid S{WSC + O_ACT, WSC + O_WFO + (size_t)(layer * 2 + f) * SZ_WFO1, DFF, rep ? 0 : 5, F.G, F.bid}; EpiResid E{XWP, (layer == 0 && s == 0) ? TABP[0] : (const float*)XWP, (float*)(F.ws + O_PART), MODP + layer * NMODC + (mi + 2) * D, rep ? 0.f : 0.5f}; gemm_phase(F.lds, F.tid, DFF, DFF, DFF, S, E); });
            } else if ((layer & 1) == 0) {
                RUNG(3, phase_norm(F, (const float*)(F.ws + O_XW), layer, 3, rep ? 0 : 5));
                RUNG(6, { Sched1 S{WSC + O_HB, WSC + O_WLI + (size_t)j * 2 * SZ_W1M, MT / 256, 8, (size_t)256 * 1024 * 2, (size_t)256 * 1024 * 2, 16, F.G, F.bid}; EpiLruIn E{(bf16_t*)(F.ws + O_GG), (float*)(F.ws + O_REC)}; gemm_phase(F.lds, F.tid, 1024, 1024, 1024, S, E); });
                RUNG(7, phase_conv(F, TABP, j));
                RUNG(8, { SchedGate S{WSC + O_XC, WSC + O_WLG + (size_t)j * SZ_WLG1, F.G, F.bid}; EpiLruGate E{(float*)(F.ws + O_AA), (float*)(F.ws + O_UU), (const bf16_t*)(F.ws + O_XC), TABP[16] + (size_t)j * 4 * 512, TABP[17] + (size_t)j * D}; gemm_phase(F.lds, F.tid, 1024, 256, 256, S, E); });
                RUNG(9, phase_scan_a(F));
                RUNG(9, phase_scan_b(F, TABP, j));
                RUNG(10, { SchedResid S{WSC + O_HB, WSC + O_WLO + (size_t)j * SZ_W1M, 1024, rep ? 0 : 4, F.G, F.bid}; EpiResid E{XWP, (const float*)XWP, (float*)(F.ws + O_PART), MODP + layer * NMODC + 5 * D, rep ? 0.f : 1.f}; gemm_phase(F.lds, F.tid, 1024, 1024, 1024, S, E); });
            } else {
                RUNG(3, phase_norm_rwkv(F, TABP, layer, j, rep ? 0 : 5));
                RUNG(11, { SchedRkv S{WSC + O_XM, WSC + O_WRKV + (size_t)j * 3 * SZ_W1M, WSC + O_WL1 + (size_t)j * SZ_WL1, j == 0 ? 6 : 7, F.G, F.bid}; EpiRkv E{(bf16_t*)(F.ws + O_R), (bf16_t*)(F.ws + O_K), (float*)(F.ws + O_V), (bf16_t*)(F.ws + O_VF), (bf16_t*)(F.ws + O_ACAT), j == 0 ? 1 : 0}; gemm_phase(F.lds, F.tid, 1024, 1024, 1024, S, E); });
                RUNG(12, { Sched1 S{WSC + O_ACAT, WSC + O_WL2 + (size_t)j * SZ_WL2, MT / 256, j == 0 ? 12 : 16, (size_t)256 * 384 * 2, (size_t)256 * 384 * 2, 6, F.G, F.bid}; EpiLora2 E{(float*)(F.ws + O_WD), (float*)(F.ws + O_AS), (float*)(F.ws + O_GS), (float*)(F.ws + O_V), (const bf16_t*)(F.ws + O_VF), TABP[22] + (size_t)j * D, TABP[25] + (size_t)j * D, TABP[28], rep}; gemm_phase(F.lds, F.tid, 384, 384, 384, S, E); });
                RUNG(13, phase_wkv(F, TABP, j));
                RUNG(10, { SchedResid S{WSC + O_HB, WSC + O_WO + (size_t)j * SZ_W1M, 1024, rep ? 0 : 4, F.G, F.bid}; EpiResid E{XWP, (const float*)XWP, (float*)(F.ws + O_PART), MODP + layer * NMODC + 5 * D, rep ? 0.f : 1.f}; gemm_phase(F.lds, F.tid, 1024, 1024, 1024, S, E); });
            }
        }
    }
    RUNG(3, phase_final(F, TABP, rep ? 0 : 5));
#undef RUNG
}

extern "C" void kernel_launch(void* const* d_in, const int* in_sizes, int n_in, void* d_out, int out_size, void* d_ws, size_t ws_size, hipStream_t stream) {
    static int grid = 0;
    if (grid == 0) {
        if (n_in != 39 || ws_size < WS_END) { fprintf(stderr, "kernel_launch: unexpected n_in %d / ws_size %zu (need %zu)\n", n_in, ws_size, (size_t)WS_END); grid = -1; return; }
        int dev = 0, cus = 0, per_cu = 0;
        hipGetDevice(&dev); hipDeviceGetAttribute(&cus, hipDeviceAttributeMultiprocessorCount, dev);
        if (hipFuncSetAttribute((const void*)mk_fwd, hipFuncAttributeMaxDynamicSharedMemorySize, LDS_BYTES) != hipSuccess) { fprintf(stderr, "kernel_launch: hipFuncSetAttribute failed\n"); grid = -1; return; }
        if (hipOccupancyMaxActiveBlocksPerMultiprocessor(&per_cu, (const void*)mk_fwd, 512, LDS_BYTES) != hipSuccess || per_cu < 1) { fprintf(stderr, "kernel_launch: occupancy query says %d\n", per_cu); per_cu = 1; }
        (void)hipGetLastError();
        grid = cus;
    }
    if (grid < 0) return;
    Args a{};
    for (int i = 0; i < 39; ++i) a.in[i] = (const float*)d_in[i];
    a.out = (float*)d_out; a.ws = (unsigned char*)d_ws;
#if MK_COOP
    if (hipMemsetAsync((char*)d_ws + O_BAR, 0, (size_t)3456 * 4, stream) != hipSuccess) { fprintf(stderr, "kernel_launch: memset failed\n"); return; }
    a.lo = 0; a.hi = NPH;
    void* kargs[] = {&a};
    hipError_t e = hipLaunchCooperativeKernel((const void*)mk_fwd, dim3(grid), dim3(512), kargs, LDS_BYTES, stream);
    if (e != hipSuccess) fprintf(stderr, "cooperative launch failed: %s (grid %d)\n", hipGetErrorString(e), grid);
#else
    for (int p = 0; p < NPH; ++p) { a.lo = p; a.hi = p + 1; hipLaunchKernelGGL(mk_fwd, dim3(grid), dim3(512), LDS_BYTES, stream, a); }
#endif
}
```
